# Optimizing an MI355X kernel written in HIP

```python
import jax, jax.numpy as jnp
from jax import lax
import numpy as np

D_MODEL = 1024
BATCH = 2
SEQ = 8192
DEPTH = 1
DEC_BATCH = 128
DEC_SEQ = 4
PAST_LEN = 2048
PAGE_SIZE = 128

N_META = 16
A_HEADS = 8
A_HEAD_DIM = 64
A_WIDTH = A_HEADS * A_HEAD_DIM
B_HEADS = 4
B_KEY_DIM = 128
B_VAL_DIM = 128
B_KEY_WIDTH = B_HEADS * B_KEY_DIM
B_WIDTH = B_HEADS * B_VAL_DIM
MIX_WIDTH = A_WIDTH + B_WIDTH
IN_SIZES = (A_WIDTH, A_WIDTH, A_WIDTH, A_HEADS, A_WIDTH, B_KEY_WIDTH, B_KEY_WIDTH, B_WIDTH, B_WIDTH)
IN_WIDTH = sum(IN_SIZES)
BLOCK = 128
CHUNK = 128
RMS_EPS = 1e-6

kernel_name = "fox_hgrn2_parallel_heads_step"


def rmsnorm(x, g):
    xf = x.astype(jnp.float32)
    y = xf * lax.rsqrt(jnp.mean(xf * xf, axis=-1, keepdims=True) + RMS_EPS)
    return (y * g.astype(jnp.float32)).astype(x.dtype)


def branch_inputs(hn, w_in, b_forget, lb):
    bsz, t = hn.shape[:2]
    u = hn @ w_in
    offs = [int(o) for o in np.cumsum(IN_SIZES)[:-1]]
    qa, ka, va, fa, za, qb, fb, vb, zb = jnp.split(u, offs, axis=-1)
    qa = qa.reshape(bsz, t, A_HEADS, A_HEAD_DIM)
    ka = ka.reshape(bsz, t, A_HEADS, A_HEAD_DIM)
    va = va.reshape(bsz, t, A_HEADS, A_HEAD_DIM)
    logf_a = jax.nn.log_sigmoid(fa.astype(jnp.float32) + b_forget.astype(jnp.float32))
    lbh = lb.reshape(B_HEADS, B_KEY_DIM)
    g = lbh + (1.0 - lbh) * jax.nn.sigmoid(fb.astype(jnp.float32).reshape(bsz, t, B_HEADS, B_KEY_DIM))
    kb = 1.0 - g
    logf_b = jnp.log(g)
    qb = jax.nn.silu(qb.astype(jnp.float32)).reshape(bsz, t, B_HEADS, B_KEY_DIM)
    vb = vb.reshape(bsz, t, B_HEADS, B_VAL_DIM)
    return qa, ka, va, logf_a, za, qb, kb, vb, logf_b, zb


def fox_attend(q, cq, k, ck, v, mask):
    scale = A_HEAD_DIM ** -0.5
    s = jnp.einsum('bqhd,bkhd->bhqk', q, k).astype(jnp.float32) * scale
    s = s + jnp.transpose(cq, (0, 2, 1))[:, :, :, None] - jnp.transpose(ck, (0, 2, 1))[:, :, None, :]
    s = jnp.where(mask, s, -jnp.inf)
    p = jax.nn.softmax(s, axis=-1)
    return jnp.einsum('bhqk,bkhd->bqhd', p.astype(v.dtype), v)


def fox_prompt(q, k, v, logf):
    bsz, L = q.shape[:2]
    c = jnp.cumsum(logf, axis=1)
    meta_mask = jnp.tril(jnp.ones((N_META, N_META), dtype=bool))
    o_meta = fox_attend(q[:, :N_META], c[:, :N_META], k[:, :N_META], c[:, :N_META], v[:, :N_META], meta_mask)
    n_blk = (L - N_META) // BLOCK
    k_pos = jnp.arange(L)

    def one_block(b):
        start = N_META + b * BLOCK
        qblk = lax.dynamic_slice_in_dim(q, start, BLOCK, axis=1)
        cblk = lax.dynamic_slice_in_dim(c, start, BLOCK, axis=1)
        q_pos = start + jnp.arange(BLOCK)
        mask = k_pos[None, :] <= q_pos[:, None]
        return fox_attend(qblk, cblk, k, c, v, mask)

    o_blocks = lax.map(one_block, jnp.arange(n_blk))
    o_real = jnp.swapaxes(o_blocks, 0, 1).reshape(bsz, n_blk * BLOCK, A_HEADS, A_HEAD_DIM)
    return jnp.concatenate([o_meta, o_real], axis=1)


def fox_sample(q, k, v, logf, past_k, past_v, past_logf):
    c_past = jnp.cumsum(past_logf.astype(jnp.float32), axis=1)
    c_new = c_past[:, -1:] + jnp.cumsum(logf, axis=1)
    keys = jnp.concatenate([past_k.astype(k.dtype), k], axis=1)
    vals = jnp.concatenate([past_v.astype(v.dtype), v], axis=1)
    c_all = jnp.concatenate([c_past, c_new], axis=1)
    P, T = past_k.shape[1], q.shape[1]
    mask = jnp.arange(P + T)[None, :] <= (P + jnp.arange(T))[:, None]
    return fox_attend(q, c_new, keys, c_all, vals, mask)


def hgrn_chunk(S0, q, k, v, logf):
    S0 = S0.astype(jnp.float32)
    q = q.astype(jnp.float32)
    k = k.astype(jnp.float32)
    v = v.astype(jnp.float32)
    b = jnp.cumsum(logf.astype(jnp.float32), axis=1)
    o_inter = jnp.einsum('bthk,bhkv->bthv', q * jnp.exp(b), S0)
    C = q.shape[1]
    causal = jnp.tril(jnp.ones((C, C), dtype=bool))
    diff = b[:, :, None] - b[:, None, :]
    decay = jnp.exp(jnp.where(causal[None, :, :, None, None], diff, -jnp.inf))
    a = jnp.einsum('bthk,bshk,btshk->bhts', q, k, decay)
    o_intra = jnp.einsum('bhts,bshv->bthv', a, v)
    b_last = b[:, -1]
    S_new = jnp.exp(b_last)[..., None] * S0 + jnp.einsum('bshk,bshv->bhkv', k * jnp.exp(b_last[:, None] - b), v)
    return o_inter + o_intra, S_new


def hgrn_prompt(q, k, v, logf):
    bsz, L = q.shape[:2]
    S0 = jnp.zeros((bsz, B_HEADS, B_KEY_DIM, B_VAL_DIM), jnp.float32)
    o_meta, S = hgrn_chunk(S0, q[:, :N_META], k[:, :N_META], v[:, :N_META], logf[:, :N_META])
    n_c = (L - N_META) // CHUNK

    def to_chunks(a):
        return jnp.swapaxes(a[:, N_META:].reshape(bsz, n_c, CHUNK, *a.shape[2:]), 0, 1)

    def step(S, xs):
        o, S = hgrn_chunk(S, *xs)
        return S, o

    S, o_c = lax.scan(step, S, (to_chunks(q), to_chunks(k), to_chunks(v), to_chunks(logf)))
    o_real = jnp.swapaxes(o_c, 0, 1).reshape(bsz, n_c * CHUNK, B_HEADS, B_VAL_DIM)
    return jnp.concatenate([o_meta, o_real], axis=1), S


def merge_heads(o_a, za, o_b, zb, out_norm, w_out):
    bsz, t = o_a.shape[:2]
    ya = o_a.reshape(bsz, t, A_WIDTH) * jax.nn.silu(za)
    yb = rmsnorm(o_b, out_norm).reshape(bsz, t, B_WIDTH) * jax.nn.silu(zb)
    return jnp.concatenate([ya.astype(yb.dtype), yb], axis=-1) @ w_out


def setup_inputs(seed: int = 0) -> dict:
    key = jax.random.key(seed)
    ks = jax.random.split(key, 16)
    n_pages = PAST_LEN // PAGE_SIZE
    n_pool = (DEC_BATCH * n_pages * 5) // 4
    f32 = jnp.float32
    x_prompt = jax.random.normal(ks[0], (BATCH, SEQ, D_MODEL), f32)
    x_sample = jax.random.normal(ks[1], (DEC_BATCH, DEC_SEQ, D_MODEL), f32)
    cache_k = jax.random.normal(ks[2], (DEPTH, n_pool, PAGE_SIZE, A_HEADS, A_HEAD_DIM), f32)
    cache_v = jax.random.normal(ks[3], (DEPTH, n_pool, PAGE_SIZE, A_HEADS, A_HEAD_DIM), f32)
    cache_logf = jax.nn.log_sigmoid(3.0 + jax.random.normal(ks[4], (DEPTH, n_pool, PAGE_SIZE, A_HEADS), f32))
    state_hgrn = jax.random.normal(ks[5], (DEPTH, DEC_BATCH, B_HEADS, B_KEY_DIM, B_VAL_DIM), f32)
    perm = jax.random.permutation(ks[6], n_pool)
    page_table = perm[: DEC_BATCH * n_pages].reshape(DEC_BATCH, n_pages).astype(jnp.int32)
    meta_tokens = jax.random.normal(ks[7], (N_META, D_MODEL), f32)
    w_in = jax.random.normal(ks[8], (DEPTH, D_MODEL, IN_WIDTH), f32) * D_MODEL ** -0.5
    b_forget = 3.0 + 0.1 * jax.random.normal(ks[9], (DEPTH, A_HEADS), f32)
    hgrn_lower_bound = 0.1 * jax.random.normal(ks[10], (DEPTH + 1, B_KEY_WIDTH), f32)
    hgrn_out_norm = 1.0 + 0.01 * jax.random.normal(ks[11], (DEPTH, B_VAL_DIM), f32)
    pre_norm = 1.0 + 0.01 * jax.random.normal(ks[12], (DEPTH, D_MODEL), f32)
    post_norm = 1.0 + 0.01 * jax.random.normal(ks[13], (DEPTH, D_MODEL), f32)
    w_out = jax.random.normal(ks[14], (DEPTH, MIX_WIDTH, D_MODEL), f32) * MIX_WIDTH ** -0.5
    return {"x_prompt": x_prompt, "x_sample": x_sample, "cache_k": cache_k, "cache_v": cache_v,
            "cache_logf": cache_logf, "state_hgrn": state_hgrn, "page_table": page_table,
            "meta_tokens": meta_tokens, "w_in": w_in, "b_forget": b_forget,
            "hgrn_lower_bound": hgrn_lower_bound, "hgrn_out_norm": hgrn_out_norm,
            "pre_norm": pre_norm, "post_norm": post_norm, "w_out": w_out}


def reference(x_prompt, x_sample, cache_k, cache_v, cache_logf, state_hgrn, page_table,
              meta_tokens, w_in, b_forget, hgrn_lower_bound, hgrn_out_norm, pre_norm, post_norm, w_out):
    bp = x_prompt.shape[0]
    bs = x_sample.shape[0]
    n_pages = page_table.shape[1]
    page = cache_k.shape[2]
    meta = jnp.broadcast_to(meta_tokens[None].astype(x_prompt.dtype), (bp, N_META, D_MODEL))
    hp = jnp.concatenate([meta, x_prompt], axis=1)
    hs = x_sample
    lb_all = jnp.cumsum(jax.nn.softmax(hgrn_lower_bound.astype(jnp.float32), axis=0), axis=0)
    pk, pv, plf, pS, sk, sv, slf, sS = [], [], [], [], [], [], [], []
    for l in range(DEPTH):
        lb = lb_all[l]
        hn = rmsnorm(hp, pre_norm[l])
        qa, ka, va, lfa, za, qb, kb, vb, lfb, zb = branch_inputs(hn, w_in[l], b_forget[l], lb)
        oa = fox_prompt(qa, ka, va, lfa)
        ob, S_p = hgrn_prompt(qb, kb, vb, lfb)
        hp = hp + rmsnorm(merge_heads(oa, za, ob, zb, hgrn_out_norm[l], w_out[l]), post_norm[l])
        pk.append(ka); pv.append(va); plf.append(lfa); pS.append(S_p)
        hn = rmsnorm(hs, pre_norm[l])
        qa, ka, va, lfa, za, qb, kb, vb, lfb, zb = branch_inputs(hn, w_in[l], b_forget[l], lb)
        past_k = cache_k[l][page_table].reshape(bs, n_pages * page, A_HEADS, A_HEAD_DIM)
        past_v = cache_v[l][page_table].reshape(bs, n_pages * page, A_HEADS, A_HEAD_DIM)
        past_lf = cache_logf[l][page_table].reshape(bs, n_pages * page, A_HEADS)
        oa = fox_sample(qa, ka, va, lfa, past_k, past_v, past_lf)
        ob, S_s = hgrn_chunk(state_hgrn[l], qb, kb, vb, lfb)
        hs = hs + rmsnorm(merge_heads(oa, za, ob, zb, hgrn_out_norm[l], w_out[l]), post_norm[l])
        sk.append(ka); sv.append(va); slf.append(lfa); sS.append(S_s)
    y_prompt = hp[:, N_META:]
    return (y_prompt, hs, jnp.stack(pk), jnp.stack(pv), jnp.stack(plf), jnp.stack(pS),
            jnp.stack(sk), jnp.stack(sv), jnp.stack(slf), jnp.stack(sS))
```

```cpp
#include <hip/hip_runtime.h>
#include <cstdio>
#include <cstdint>
namespace pg8 {
#define PG8_LAS __attribute__((address_space(3)))
typedef unsigned short bf16_t;
typedef short bf16x8 __attribute__((ext_vector_type(8)));
typedef float f32x4 __attribute__((ext_vector_type(4)));
typedef unsigned u32x4 __attribute__((ext_vector_type(4)));
constexpr int BM = 256, BK = 64, HALF = 128, HTB = HALF * BK * 2  , STAGE_BYTES = 8 * HTB, NXCD = 8, WGM = 8;

__host__ __device__ __forceinline__ int lds_byte(int r, int c) { const int st = (r >> 4) * 2 + (c >> 5), rr = r & 15, cc = c & 31, ob = rr * 64 + cc * 2; return st * 1024 + (ob ^ (((ob >> 9) & 1) << 5)); }
__host__ __device__ __forceinline__ void stage_rc(int b, int& R, int& C) { const int st = b / 1024, sb = b % 1024, swz = sb ^ (((sb >> 9) & 1) << 5); R = (st >> 1) * 16 + swz / 64; C = (st & 1) * 32 + (swz % 64) / 2; }
__host__ __device__ __forceinline__ int perm32(int rho) { const int n = rho >> 4, i = rho & 15; return 8 * (i >> 2) + 4 * n + (i & 3); }

struct Unit { int pm, pn; };
struct Gemm { const bf16_t* A; const bf16_t* Bt; int M, N, K; };

struct StaticOrder {
    int nM, nN, nwg, G, c;
    __host__ __device__ void init(int M, int N, int G_, int c_) { nM = M / BM; nN = N / BM; nwg = nM * nN; G = G_; c = c_; }
    __host__ __device__ bool next(int i, Unit& u) const {
        const long L = (long)i * G + c; if (L >= nwg) return false;
        int wgid = (int)L; { const int q = nwg / NXCD, r = nwg % NXCD, xcd = wgid % NXCD, off = wgid / NXCD; wgid = (xcd < r ? xcd * (q + 1) : r * (q + 1) + (xcd - r) * q) + off; }
        const int nig = WGM * nN, gid = wgid / nig, fm = gid * WGM, gsz = (nM - fm) < WGM ? (nM - fm) : WGM;
        u.pm = fm + ((wgid % nig) % gsz); u.pn = (wgid % nig) / gsz; return true;
    }
    __device__ __forceinline__ void a_ready(const Unit&) const {}
    __device__ __forceinline__ void done(const Unit&) const {}
};

__device__ __forceinline__ unsigned cvt_pk_bf16(float lo, float hi) { unsigned r; asm volatile("v_cvt_pk_bf16_f32 %0, %1, %2" : "=v"(r) : "v"(lo), "v"(hi)); return r; }
typedef float f32x2 __attribute__((ext_vector_type(2)));
template <class Epi, class Sched, bool ALIGN_EPI = false, bool SP2 = false>
__device__ __forceinline__ void gemm_phase(PG8_LAS unsigned char* lds, const Gemm g, const Sched& S, const Epi& E) {
    const int tid = threadIdx.x, wid = __builtin_amdgcn_readfirstlane(tid >> 6), lane = tid & 63, wr = wid >> 2, wc = wid & 3, fr = lane & 15, fq = lane >> 4;
    const int K = g.K, nt = K / BK;
    unsigned voffA[2], voffB[2];
#pragma unroll
    for (int i = 0; i < 2; ++i) { int R, C; stage_rc(tid * 16 + i * 8192, R, C); const int Rb = Epi::PERM ? ((R & ~31) + perm32(R & 31)) : R;
        voffA[i] = (unsigned)(R * K + C) * 2u; voffB[i] = (unsigned)(Rb * K + C) * 2u; }
    const size_t kstep = (size_t)(BK * 2);
    const size_t hstep = (size_t)HALF * K * 2;
    const size_t tstep = 2 * hstep;
    const unsigned ldsw = (unsigned)wid * 1024u;
    const int aoff = lds_byte(wr * 64 + fr, fq * 8), boff = lds_byte(wc * 32 + fr, fq * 8);
#define PG8_SA(b, h) (((b) * 2 + (h)) * HTB)
#define PG8_SB(b, h) ((4 + (b) * 2 + (h)) * HTB)
#define PG8_STAGE(bufoff, gbase, voff) do { _Pragma("unroll") for (int _i = 0; _i < 2; ++_i) \
        __builtin_amdgcn_global_load_lds((const unsigned*)((const char*)(gbase) + (voff)[_i]), (PG8_LAS unsigned*)(lds + (bufoff) + ldsw + _i * 8192), 16, 0, 0); } while (0)
#define PG8_LDA(dst, b, h) do { _Pragma("unroll") for (int m = 0; m < 4; ++m) _Pragma("unroll") for (int k = 0; k < 2; ++k) dst[m][k] = *(const PG8_LAS bf16x8*)(lds + PG8_SA(b, h) + aoff + m * 2048 + k * 1024); } while (0)
#define PG8_LDB(dst, b, h) do { _Pragma("unroll") for (int n = 0; n < 2; ++n) _Pragma("unroll") for (int k = 0; k < 2; ++k) dst[n][k] = *(const PG8_LAS bf16x8*)(lds + PG8_SB(b, h) + boff + n * 2048 + k * 1024); } while (0)
#define PG8_MMA(ai, bj, At, Bt) do { __builtin_amdgcn_s_setprio(1); _Pragma("unroll") for (int m = 0; m < 4; ++m) _Pragma("unroll") for (int n = 0; n < 2; ++n) _Pragma("unroll") for (int k = 0; k < 2; ++k) \
        acc[ai][bj][m][n] = __builtin_amdgcn_mfma_f32_16x16x32_bf16(Bt[n][k], At[m][k], acc[ai][bj][m][n], 0, 0, 0); __builtin_amdgcn_s_setprio(0); } while (0)
#define PG8_WAIT_V(n) asm volatile("s_waitcnt vmcnt(" #n ")" ::: "memory")
#define PG8_WAIT_L(n) asm volatile("s_waitcnt lgkmcnt(" #n ")" ::: "memory")
#define PG8_BAR __builtin_amdgcn_s_barrier()
#define PG8_SCHED __builtin_amdgcn_sched_barrier(0)
    Unit cur, nxt; int ui = 0;
    if (!S.next(0, cur)) return;
    f32x4 acc[2][2][4][2];
#pragma unroll
    for (int a = 0; a < 2; ++a)
#pragma unroll
        for (int b = 0; b < 2; ++b)
#pragma unroll
            for (int m = 0; m < 4; ++m)
#pragma unroll
                for (int n = 0; n < 2; ++n) acc[a][b][m][n] = (f32x4){0.f, 0.f, 0.f, 0.f};
    bf16x8 At[4][2], B0[2][2], B1[2][2];
    const char* cA = (const char*)g.A + (size_t)cur.pm * tstep; const char* cB = (const char*)g.Bt + (size_t)cur.pn * tstep;
    S.a_ready(cur);
    if constexpr (SP2) {
        PG8_STAGE(PG8_SB(0, 0), cB, voffB); PG8_STAGE(PG8_SB(0, 1), cB + hstep, voffB); PG8_STAGE(PG8_SA(0, 0), cA, voffA); PG8_STAGE(PG8_SA(0, 1), cA + hstep, voffA);
        if (wr == 1) PG8_BAR;
        PG8_WAIT_V(2); PG8_BAR;
        PG8_STAGE(PG8_SB(1, 0), cB + kstep, voffB); PG8_STAGE(PG8_SA(1, 0), cA + kstep, voffA); PG8_STAGE(PG8_SB(1, 1), cB + hstep + kstep, voffB);
        PG8_WAIT_V(6); PG8_BAR;
    } else {
        PG8_STAGE(PG8_SB(0, 0), cB, voffB); PG8_STAGE(PG8_SA(0, 0), cA, voffA); PG8_STAGE(PG8_SB(0, 1), cB + hstep, voffB); PG8_STAGE(PG8_SA(0, 1), cA + hstep, voffA);
        if (wr == 1) PG8_BAR;
        PG8_WAIT_V(4); PG8_BAR;
        PG8_STAGE(PG8_SB(1, 0), cB + kstep, voffB); PG8_STAGE(PG8_SA(1, 0), cA + kstep, voffA); PG8_STAGE(PG8_SB(1, 1), cB + hstep + kstep, voffB);
        PG8_WAIT_V(6); PG8_BAR;
    }
    for (;;) {
        const bool has_next = S.next(ui + 1, nxt);
        const char* nA = has_next ? (const char*)g.A + (size_t)nxt.pm * tstep : cA; const char* nB = has_next ? (const char*)g.Bt + (size_t)nxt.pn * tstep : cB;
        for (int t = 0; t < nt; t += 2) {
            const bool last = (t == nt - 2);
            const char* a1 = cA + (size_t)(t + 1) * kstep;
            const char* a2 = last ? nA : cA + (size_t)(t + 2) * kstep; const char* b2 = last ? nB : cB + (size_t)(t + 2) * kstep;
            const char* a3 = a2 + kstep; const char* b3 = b2 + kstep;
            if (last && has_next) S.a_ready(nxt);
            if constexpr (SP2) {
            PG8_LDB(B0, 0, 0); PG8_LDB(B1, 0, 1); PG8_SCHED; PG8_LDA(At, 0, 0); PG8_STAGE(PG8_SA(1, 1), a1 + hstep, voffA);
            PG8_WAIT_V(8); PG8_WAIT_L(0); PG8_BAR; PG8_MMA(0, 0, At, B0); PG8_MMA(0, 1, At, B1); PG8_BAR; PG8_SCHED;
            PG8_LDA(At, 0, 1); PG8_STAGE(PG8_SB(0, 0), b2, voffB); PG8_STAGE(PG8_SB(0, 1), b2 + hstep, voffB); PG8_STAGE(PG8_SA(0, 0), a2, voffA);
            PG8_WAIT_V(8); PG8_WAIT_L(0); PG8_BAR; PG8_MMA(1, 0, At, B0); PG8_MMA(1, 1, At, B1); PG8_BAR; PG8_SCHED;
            PG8_LDB(B0, 1, 0); PG8_LDB(B1, 1, 1); PG8_SCHED; PG8_LDA(At, 1, 0); PG8_STAGE(PG8_SA(0, 1), a2 + hstep, voffA);
            PG8_WAIT_V(8); PG8_WAIT_L(0); PG8_BAR; PG8_MMA(0, 0, At, B0); PG8_MMA(0, 1, At, B1); PG8_BAR; PG8_SCHED;
            PG8_LDA(At, 1, 1); PG8_STAGE(PG8_SB(1, 0), b3, voffB); PG8_STAGE(PG8_SB(1, 1), b3 + hstep, voffB); PG8_STAGE(PG8_SA(1, 0), a3, voffA);
            PG8_WAIT_V(8); PG8_WAIT_L(0); PG8_BAR; PG8_MMA(1, 0, At, B0); PG8_MMA(1, 1, At, B1); PG8_BAR; PG8_SCHED;
            } else {
            PG8_LDB(B0, 0, 0); PG8_SCHED; PG8_LDA(At, 0, 0); PG8_STAGE(PG8_SA(1, 1), a1 + hstep, voffA);
            PG8_WAIT_L(8); PG8_BAR; PG8_WAIT_L(0); PG8_MMA(0, 0, At, B0); PG8_BAR; PG8_SCHED;
            PG8_LDB(B1, 0, 1); PG8_STAGE(PG8_SB(0, 0), b2, voffB);
            PG8_BAR; PG8_WAIT_L(0); PG8_MMA(0, 1, At, B1); PG8_BAR;
            PG8_LDA(At, 0, 1); PG8_STAGE(PG8_SA(0, 0), a2, voffA);
            PG8_BAR; PG8_WAIT_L(0); PG8_MMA(1, 0, At, B0); PG8_BAR; PG8_SCHED;
            PG8_STAGE(PG8_SB(0, 1), b2 + hstep, voffB);
            PG8_WAIT_V(6); PG8_BAR; PG8_MMA(1, 1, At, B1); PG8_BAR;
            PG8_LDB(B0, 1, 0); PG8_SCHED; PG8_LDA(At, 1, 0); PG8_STAGE(PG8_SA(0, 1), a2 + hstep, voffA);
            PG8_WAIT_L(8); PG8_BAR; PG8_WAIT_L(0); PG8_MMA(0, 0, At, B0); PG8_BAR; PG8_SCHED;
            PG8_LDB(B1, 1, 1); PG8_STAGE(PG8_SB(1, 0), b3, voffB);
            PG8_BAR; PG8_WAIT_L(0); PG8_MMA(0, 1, At, B1); PG8_BAR;
            PG8_LDA(At, 1, 1); PG8_STAGE(PG8_SA(1, 0), a3, voffA);
            PG8_BAR; PG8_WAIT_L(0); PG8_MMA(1, 0, At, B0); PG8_BAR; PG8_SCHED;
            PG8_STAGE(PG8_SB(1, 1), b3 + hstep, voffB);
            PG8_WAIT_V(6); PG8_BAR; PG8_MMA(1, 1, At, B1); PG8_BAR;
            }
        }
        if constexpr (ALIGN_EPI) { if (wr == 0) PG8_BAR; }
        if constexpr (!Epi::AFTER_DRAIN) { E(acc, cur, wr, wc, fr, fq); S.done(cur); }
        if (!has_next) break;
#pragma unroll
        for (int a = 0; a < 2; ++a)
#pragma unroll
            for (int b = 0; b < 2; ++b)
#pragma unroll
                for (int m = 0; m < 4; ++m)
#pragma unroll
                    for (int n = 0; n < 2; ++n) acc[a][b][m][n] = (f32x4){0.f, 0.f, 0.f, 0.f};
        cur = nxt; cA = nA; cB = nB; ++ui;
        if constexpr (ALIGN_EPI) { if (wr == 1) PG8_BAR; }
    }
    PG8_WAIT_V(0);
    if constexpr (!ALIGN_EPI) { if (wr == 0) PG8_BAR; }
    PG8_BAR;
    if constexpr (Epi::AFTER_DRAIN) { E.fused(acc, cur, wr, wc, fr, fq, lds, wid, lane); S.done(cur); }
#undef PG8_SA
#undef PG8_SB
#undef PG8_STAGE
#undef PG8_LDA
#undef PG8_LDB
#undef PG8_MMA
#undef PG8_WAIT_V
#undef PG8_WAIT_L
#undef PG8_BAR
#undef PG8_SCHED
}
}

#ifndef MK_FUSED
#define MK_FUSED 1
#endif
#define LAS __attribute__((address_space(3)))
typedef unsigned short bf16_t;
typedef short bf16x8 __attribute__((ext_vector_type(8)));
typedef float f32x4 __attribute__((ext_vector_type(4)));
typedef float f32x16 __attribute__((ext_vector_type(16)));
typedef unsigned u32x4 __attribute__((ext_vector_type(4)));
typedef unsigned u32x2 __attribute__((ext_vector_type(2)));

constexpr int DMODEL = 1024, SEQ = 8192, NMETA = 16, LP = SEQ + NMETA;
constexpr int PADF = 112, RB = 8320;
constexpr int NBATCH = 2, MP = NBATCH * RB;
constexpr int NS = 128, ST = 4, MS = NS * ST;
constexpr int MT = MP + MS;
constexpr int AH = 8, AW = 512, BH = 4, BW = 512;
constexpr int INW = 4104, NPAGE = 16, PAGE = 128;
constexpr int NCH = 130;
constexpr float LOG2E = 1.4426950408889634f;
constexpr float QSCALE = 0.125f * LOG2E;
constexpr float RMS_EPS = 1e-6f;

constexpr size_t OFF_YP = 0, OFF_YS = OFF_YP + (size_t)NBATCH * SEQ * DMODEL, OFF_PK = OFF_YS + (size_t)MS * DMODEL, OFF_PV = OFF_PK + (size_t)NBATCH * LP * AW,
                 OFF_PLF = OFF_PV + (size_t)NBATCH * LP * AW, OFF_PST = OFF_PLF + (size_t)NBATCH * LP * AH, OFF_SK = OFF_PST + (size_t)NBATCH * BH * 128 * 128,
                 OFF_SV = OFF_SK + (size_t)MS * AW, OFF_SLF = OFF_SV + (size_t)MS * AW, OFF_SST = OFF_SLF + (size_t)MS * AH, OUT_TOTAL = OFF_SST + (size_t)NS * BH * 128 * 128;
static_assert(OUT_TOTAL == 43290880, "output size");

constexpr size_t MiB = 1u << 20;
constexpr size_t WS_CTL = 0, CTL_BYTES = 1 * MiB;
constexpr size_t WS_WIN = 1 * MiB;
constexpr size_t WS_WOUT = 9 * MiB;
constexpr size_t WS_HN = 12 * MiB;
constexpr size_t ACT = (size_t)MT * 512 * 2;
constexpr size_t WS_QA = 48 * MiB, WS_KA = WS_QA + 17 * MiB, WS_VA = WS_KA + 17 * MiB, WS_GA = WS_VA + 17 * MiB, WS_QB = WS_GA + 17 * MiB,
                 WS_KB = WS_QB + 17 * MiB, WS_VB = WS_KB + 17 * MiB, WS_GB = WS_VB + 17 * MiB;
constexpr size_t WS_LFB = 184 * MiB;
constexpr size_t WS_LFA = 218 * MiB;
constexpr size_t WS_CA = 219 * MiB;
constexpr size_t WS_PSUM = 220 * MiB;
constexpr size_t WS_PM = 221 * MiB, WS_PL = 222 * MiB;
constexpr size_t WS_PO = 223 * MiB;
constexpr size_t WS_DCH = 240 * MiB;
constexpr size_t WS_Y = 256 * MiB;
constexpr size_t WS_TMP = 292 * MiB;
constexpr size_t WS_SLOC = 360 * MiB;
constexpr size_t WS_SST = 428 * MiB;
constexpr size_t WS_END = 464 * MiB;
static_assert(ACT <= 17 * MiB && (size_t)MT * 1024 * 2 <= 36 * MiB && (size_t)MT * 1024 * 4 <= 68 * MiB && (size_t)8 * NCH * 16384 * 4 <= 68 * MiB, "ws map");

constexpr int LDS_BYTES = 147456;
constexpr int NTHREADS = 512;

struct Args {
    const float *x_prompt, *x_sample, *cache_k, *cache_v, *cache_logf, *state_hgrn; const int* page_table;
    const float *meta, *w_in, *b_forget, *lb_raw, *out_norm, *pre_norm, *post_norm, *w_out;
    float* out; unsigned char* ws; int ph_lo, ph_hi;
};

__device__ __forceinline__ float bf2f(bf16_t v) { return __uint_as_float((unsigned)v << 16); }
__device__ __forceinline__ unsigned f2bf(float f) { unsigned u = __float_as_uint(f); return (u + 0x7fffu + ((u >> 16) & 1u)) >> 16; }
__device__ __forceinline__ unsigned pk2(float lo, float hi) { return f2bf(lo) | (f2bf(hi) << 16); }
__device__ __forceinline__ float wave_sum(float v) {
#pragma unroll
    for (int o = 1; o < 64; o <<= 1) v += __shfl_xor(v, o);
    return v;
}
__device__ __forceinline__ float fexp2(float x) { return __builtin_amdgcn_exp2f(x); }
__device__ __forceinline__ float silu(float x) { return x / (1.0f + __expf(-x)); }
__device__ __forceinline__ int crow(int r, int hi) { return (r & 3) + 8 * (r >> 2) + 4 * hi; }

struct EpiIn {
    static constexpr bool PERM = true, AFTER_DRAIN = false;
    unsigned char* ws; float* out; const float* lb_raw;
    __device__ __forceinline__ static float* kv_row(float* pk, float* sk, int row) {
        if (row >= MP) return sk + (size_t)(row - MP) * 512;
        const int b = row >= RB; const int p = row - b * RB; if (p < PADF) return nullptr;
        return pk + ((size_t)b * LP + (p - PADF)) * 512;
    }
    __device__ __forceinline__ void operator()(const pg8::f32x4 (&acc)[2][2][4][2], const pg8::Unit& u, int wr, int wc, int fr, int fq) const {
        const int sec = u.pn >> 1;
        const int row0 = u.pm * 256 + wr * 64 + fr;
        const int col0 = (u.pn & 1) * 256 + wc * 32 + 8 * fq;
        bf16_t* dst = (bf16_t*)(ws + WS_QA + (size_t)sec * 17 * MiB);
        if (sec == 0 || sec == 6) {
            const float sc = (sec == 0) ? QSCALE : 1.0f;
#pragma unroll
            for (int ai = 0; ai < 2; ++ai)
#pragma unroll
                for (int m = 0; m < 4; ++m) { const int row = row0 + ai * 128 + m * 16;
#pragma unroll
                    for (int bj = 0; bj < 2; ++bj) { const f32x4 v0 = acc[ai][bj][m][0] * sc, v1 = acc[ai][bj][m][1] * sc;
                        u32x4 w; w.x = pk2(v0[0], v0[1]); w.y = pk2(v0[2], v0[3]); w.z = pk2(v1[0], v1[1]); w.w = pk2(v1[2], v1[3]);
                        *(u32x4*)(dst + (size_t)row * 512 + col0 + bj * 128) = w; } }
        } else if (sec == 1 || sec == 2) {
            float* pk = out + (sec == 1 ? OFF_PK : OFF_PV); float* sk = out + (sec == 1 ? OFF_SK : OFF_SV);
#pragma unroll
            for (int ai = 0; ai < 2; ++ai)
#pragma unroll
                for (int m = 0; m < 4; ++m) { const int row = row0 + ai * 128 + m * 16; float* orow = kv_row(pk, sk, row);
#pragma unroll
                    for (int bj = 0; bj < 2; ++bj) { const f32x4 v0 = acc[ai][bj][m][0], v1 = acc[ai][bj][m][1];
                        u32x4 w; w.x = pk2(v0[0], v0[1]); w.y = pk2(v0[2], v0[3]); w.z = pk2(v1[0], v1[1]); w.w = pk2(v1[2], v1[3]);
                        *(u32x4*)(dst + (size_t)row * 512 + col0 + bj * 128) = w;
                        if (orow) { *(f32x4*)(orow + col0 + bj * 128) = v0; *(f32x4*)(orow + col0 + bj * 128 + 4) = v1; } } }
        } else if (sec == 5) {
            float oml[2][8];
#pragma unroll
            for (int bj = 0; bj < 2; ++bj)
#pragma unroll
                for (int e = 0; e < 8; ++e) { const int c = col0 + bj * 128 + e; const float a0 = lb_raw[c], a1 = lb_raw[512 + c]; oml[bj][e] = 1.0f / (1.0f + __expf(a0 - a1)); }
            float* lfb = (float*)(ws + WS_LFB);
#pragma unroll
            for (int ai = 0; ai < 2; ++ai)
#pragma unroll
                for (int m = 0; m < 4; ++m) { const int row = row0 + ai * 128 + m * 16;
                    bool padrow = false; if (row < MP) { const int p = row - (row >= RB ? RB : 0); padrow = p < PADF; }
#pragma unroll
                    for (int bj = 0; bj < 2; ++bj) { float kk[8], lg[8];
#pragma unroll
                        for (int e = 0; e < 8; ++e) { const float x = acc[ai][bj][m][e >> 2][e & 3]; float k1 = oml[bj][e] / (1.0f + __expf(x)); float l1 = __logf(1.0f - k1);
                            if (padrow) { k1 = 0.f; l1 = 0.f; } kk[e] = k1; lg[e] = l1; }
                        u32x4 w; w.x = pk2(kk[0], kk[1]); w.y = pk2(kk[2], kk[3]); w.z = pk2(kk[4], kk[5]); w.w = pk2(kk[6], kk[7]);
                        *(u32x4*)(dst + (size_t)row * 512 + col0 + bj * 128) = w;
                        *(f32x4*)(lfb + (size_t)row * 512 + col0 + bj * 128) = (f32x4){lg[0], lg[1], lg[2], lg[3]};
                        *(f32x4*)(lfb + (size_t)row * 512 + col0 + bj * 128 + 4) = (f32x4){lg[4], lg[5], lg[6], lg[7]}; } }
        } else {
#pragma unroll
            for (int ai = 0; ai < 2; ++ai)
#pragma unroll
                for (int m = 0; m < 4; ++m) { const int row = row0 + ai * 128 + m * 16;
#pragma unroll
                    for (int bj = 0; bj < 2; ++bj) { const f32x4 v0 = acc[ai][bj][m][0], v1 = acc[ai][bj][m][1];
                        u32x4 w; w.x = pk2(silu(v0[0]), silu(v0[1])); w.y = pk2(silu(v0[2]), silu(v0[3])); w.z = pk2(silu(v1[0]), silu(v1[1])); w.w = pk2(silu(v1[2]), silu(v1[3]));
                        *(u32x4*)(dst + (size_t)row * 512 + col0 + bj * 128) = w; } }
        }
    }
};
struct EpiOut {
    static constexpr bool PERM = true, AFTER_DRAIN = false;
    float* tmp;
    __device__ __forceinline__ void operator()(const pg8::f32x4 (&acc)[2][2][4][2], const pg8::Unit& u, int wr, int wc, int fr, int fq) const {
        const int row0 = u.pm * 256 + wr * 64 + fr, col0 = u.pn * 256 + wc * 32 + 8 * fq;
#pragma unroll
        for (int ai = 0; ai < 2; ++ai)
#pragma unroll
            for (int m = 0; m < 4; ++m) { float* rp = tmp + (size_t)(row0 + ai * 128 + m * 16) * 1024 + col0;
#pragma unroll
                for (int bj = 0; bj < 2; ++bj) { *(f32x4*)(rp + bj * 128) = acc[ai][bj][m][0]; *(f32x4*)(rp + bj * 128 + 4) = acc[ai][bj][m][1]; } }
    }
};

__device__ __forceinline__ void transpose_item(const float* W, int ldw, int c0, int nblk, bf16_t* WT, int K, int row_off, LAS float* scr, int item, int lane) {
    const int kb = item / nblk, nb = item % nblk, k0 = 64 * kb, n0 = 32 * nb;
#pragma unroll 8
    for (int i = 0; i < 32; ++i) { const int kk = 2 * i + (lane >> 5); scr[kk * 33 + (lane & 31)] = W[(size_t)(k0 + kk) * ldw + c0 + n0 + (lane & 31)]; }
    asm volatile("s_waitcnt lgkmcnt(0)" ::: "memory");
    const int c = lane & 7;
#pragma unroll
    for (int j = 0; j < 4; ++j) { const int n = (lane >> 3) + 8 * j; const LAS float* s = scr + (8 * c) * 33 + n;
        u32x4 o; o.x = pk2(s[0 * 33], s[1 * 33]); o.y = pk2(s[2 * 33], s[3 * 33]); o.z = pk2(s[4 * 33], s[5 * 33]); o.w = pk2(s[6 * 33], s[7 * 33]);
        *(u32x4*)(WT + (size_t)(row_off + n0 + n) * K + k0 + 8 * c) = o; }
    asm volatile("s_waitcnt lgkmcnt(0)" ::: "memory");
}
__device__ __forceinline__ void phase_prologue(const Args& A, int vb, int nvb, LAS unsigned char* lds) {
    const int tid = threadIdx.x, lane = tid & 63, wave = tid >> 6, gw = vb * 8 + wave, NGW = nvb * 8;
    unsigned char* ws = A.ws;
    {   LAS float* scr = (LAS float*)(lds + wave * 8448);
        const int secoff[8] = {0, 512, 1024, 1544, 2056, 2568, 3080, 3592};
        bf16_t* WinT = (bf16_t*)(ws + WS_WIN); bf16_t* WoutT = (bf16_t*)(ws + WS_WOUT);
        for (int it = gw; it < 2048 + 512; it += NGW) {
            if (it < 2048) { const int s = it >> 8; int c0 = 0;
#pragma unroll
                for (int q = 0; q < 8; ++q) if (s == q) c0 = secoff[q];
                transpose_item(A.w_in, INW, c0, 16, WinT, 1024, s * 512, scr, it & 255, lane); }
            else transpose_item(A.w_out, 1024, 0, 32, WoutT, 1024, 0, scr, it - 2048, lane);
        }
    }
    LAS float* W8 = (LAS float*)(lds + 73728);
    for (int i = tid; i < 8192; i += NTHREADS) { const int h = i & 7, k = i >> 3; W8[h * 1024 + k] = A.w_in[(size_t)k * INW + 1536 + h]; }
    __syncthreads();
    {   f32x4 g[4];
#pragma unroll
        for (int j = 0; j < 4; ++j) g[j] = ((const f32x4*)A.pre_norm)[lane + 64 * j];
        bf16_t* HN = (bf16_t*)(ws + WS_HN); float* LFA = (float*)(ws + WS_LFA);
        const float bfv = A.b_forget[lane & 7];
        for (int r = gw; r < MT; r += NGW) {
            const float* src = nullptr; float* lf_out = nullptr;
            if (r < MP) { const int b = r >= RB; const int p = r - b * RB;
                if (p >= 128) src = A.x_prompt + ((size_t)b * SEQ + (p - 128)) * 1024; else if (p >= PADF) src = A.meta + (size_t)(p - PADF) * 1024;
                if (p >= PADF) lf_out = A.out + OFF_PLF + ((size_t)b * LP + (p - PADF)) * 8; }
            else { src = A.x_sample + (size_t)(r - MP) * 1024; lf_out = A.out + OFF_SLF + (size_t)(r - MP) * 8; }
            f32x4 v[4]; float ss = 0.f;
#pragma unroll
            for (int j = 0; j < 4; ++j) { v[j] = src ? ((const f32x4*)src)[lane + 64 * j] : (f32x4){0.f, 0.f, 0.f, 0.f}; ss += (v[j].x * v[j].x + v[j].y * v[j].y) + (v[j].z * v[j].z + v[j].w * v[j].w); }
            ss = wave_sum(ss); const float rstd = 1.0f / sqrtf(ss * (1.0f / 1024.0f) + RMS_EPS);
#pragma unroll
            for (int j = 0; j < 4; ++j) { v[j] = v[j] * rstd * g[j];
                u32x2 w; w.x = pk2(v[j].x, v[j].y); w.y = pk2(v[j].z, v[j].w); ((u32x2*)(HN + (size_t)r * 1024))[lane + 64 * j] = w; }
            float mine = 0.f;
#pragma unroll
            for (int h = 0; h < 8; ++h) { float a = 0.f;
#pragma unroll
                for (int j = 0; j < 4; ++j) { const f32x4 w = *(const LAS f32x4*)(W8 + h * 1024 + 4 * lane + 256 * j); a += (v[j].x * w.x + v[j].y * w.y) + (v[j].z * w.z + v[j].w * w.w); }
                a = wave_sum(a); if (lane == h) mine = a; }
            if (lane < 8) { const float x = mine + bfv; float lf = fminf(x, 0.f) - log1pf(__expf(-fabsf(x))); if (!src) lf = 0.f;
                LFA[(size_t)r * 8 + lane] = lf; if (lf_out) lf_out[lane] = lf; }
        }
    }
    {   float* PSUM = (float*)(ws + WS_PSUM);
        for (int u = gw; u < NS * NPAGE; u += NGW) { const int page = A.page_table[u]; const f32x4* src = (const f32x4*)(A.cache_logf + (size_t)page * 1024);
            f32x4 a = (src[lane] + src[lane + 64]) + (src[lane + 128] + src[lane + 192]);
#pragma unroll
            for (int o = 2; o < 64; o <<= 1) { a.x += __shfl_xor(a.x, o); a.y += __shfl_xor(a.y, o); a.z += __shfl_xor(a.z, o); a.w += __shfl_xor(a.w, o); }
            if (lane < 2) *(f32x4*)(PSUM + (size_t)u * 8 + 4 * lane) = a; }
    }
}
__device__ __forceinline__ void phase_cumsum(const Args& A, int vb, int nvb) {
    const int lane = threadIdx.x & 63, gw = vb * 8 + (threadIdx.x >> 6), NGW = nvb * 8;
    const float* LFA = (const float*)(A.ws + WS_LFA); float* CA = (float*)(A.ws + WS_CA);
    for (int t = gw; t < NBATCH * AH; t += NGW) { const int b = t >> 3, h = t & 7; float run = 0.f;
        for (int p0 = 0; p0 < RB; p0 += 64) { const size_t idx = ((size_t)b * RB + p0 + lane) * 8 + h; float x = LFA[idx];
#pragma unroll
            for (int o = 1; o < 64; o <<= 1) { const float y = __shfl_up(x, o); if (lane >= o) x += y; }
            x += run; CA[idx] = x * LOG2E; run = __shfl(x, 63); } }
}
__device__ __forceinline__ void attn_task(const Args& A, int b, int h, int qi, int lane) {
    const bf16_t* QA = (const bf16_t*)(A.ws + WS_QA); const bf16_t* KA = (const bf16_t*)(A.ws + WS_KA); const bf16_t* VA = (const bf16_t*)(A.ws + WS_VA);
    const bf16_t* GA = (const bf16_t*)(A.ws + WS_GA); const float* CA = (const float*)(A.ws + WS_CA); bf16_t* Y = (bf16_t*)(A.ws + WS_Y);
    const int r32 = lane & 31, hi = lane >> 5;
    const size_t rowq0 = (size_t)b * RB + 96 + 32 * qi;
    bf16x8 qf[4];
#pragma unroll
    for (int d0 = 0; d0 < 4; ++d0) qf[d0] = *(const bf16x8*)(QA + (rowq0 + r32) * 512 + h * 64 + d0 * 16 + hi * 8);
    const int pq = 96 + 32 * qi + r32, pqe = pq > PADF ? pq : PADF;
    const float cq = CA[(rowq0 + r32) * 8 + h];
    float m = -1e30f, lh = 0.f; f32x16 o0, o1;
#pragma unroll
    for (int r = 0; r < 16; ++r) { o0[r] = 0.f; o1[r] = 0.f; }
    for (int kt = 0; kt <= qi; ++kt) {
        const size_t kr0 = (size_t)b * RB + 96 + 32 * kt;
        f32x16 s;
#pragma unroll
        for (int r = 0; r < 16; ++r) s[r] = 0.f;
#pragma unroll
        for (int d0 = 0; d0 < 4; ++d0) { const bf16x8 kf = *(const bf16x8*)(KA + (kr0 + r32) * 512 + h * 64 + d0 * 16 + hi * 8); s = __builtin_amdgcn_mfma_f32_32x32x16_bf16(kf, qf[d0], s, 0, 0, 0); }
        float rm = -1e30f;
#pragma unroll
        for (int r = 0; r < 16; ++r) { const int kv = crow(r, hi); const float ck = CA[(kr0 + kv) * 8 + h]; const int pk = 96 + 32 * kt + kv;
            float v = s[r] + (cq - ck); const bool ok = (pk >= PADF) && (pk <= pqe); v = ok ? v : -1e30f; s[r] = v; rm = fmaxf(rm, v); }
        rm = fmaxf(rm, __shfl_xor(rm, 32));
        const float mn = fmaxf(m, rm), alpha = fexp2(m - mn); m = mn;
        float ps = 0.f;
#pragma unroll
        for (int r = 0; r < 16; ++r) { const float p = fexp2(s[r] - mn); s[r] = p; ps += p; }
        lh = lh * alpha + ps;
#pragma unroll
        for (int r = 0; r < 16; ++r) { const float a = __shfl(alpha, crow(r, hi)); o0[r] *= a; o1[r] *= a; }
        u32x4 pw0, pw1;
        pw0.x = pk2(s[0], s[1]); pw0.y = pk2(s[2], s[3]); pw0.z = pk2(s[4], s[5]); pw0.w = pk2(s[6], s[7]);
        pw1.x = pk2(s[8], s[9]); pw1.y = pk2(s[10], s[11]); pw1.z = pk2(s[12], s[13]); pw1.w = pk2(s[14], s[15]);
        const bf16x8 pa0 = __builtin_bit_cast(bf16x8, pw0), pa1 = __builtin_bit_cast(bf16x8, pw1);
#pragma unroll
        for (int ss = 0; ss < 2; ++ss) {
            bf16x8 vf0, vf1;
#pragma unroll
            for (int j = 0; j < 8; ++j) { const int kv = 16 * ss + 8 * (j >> 2) + 4 * hi + (j & 3); const bf16_t* vp = VA + (kr0 + kv) * 512 + h * 64 + r32; vf0[j] = (short)vp[0]; vf1[j] = (short)vp[32]; }
            o0 = __builtin_amdgcn_mfma_f32_32x32x16_bf16(ss ? pa1 : pa0, vf0, o0, 0, 0, 0);
            o1 = __builtin_amdgcn_mfma_f32_32x32x16_bf16(ss ? pa1 : pa0, vf1, o1, 0, 0, 0);
        }
    }
    const float L = lh + __shfl_xor(lh, 32), linv = 1.0f / L;
#pragma unroll
    for (int r = 0; r < 16; ++r) { const int q = crow(r, hi); const float li = __shfl(linv, q); const size_t row = rowq0 + q;
        const float g0 = bf2f(GA[row * 512 + h * 64 + r32]), g1 = bf2f(GA[row * 512 + h * 64 + 32 + r32]);
        Y[row * 1024 + h * 64 + r32] = (bf16_t)f2bf(o0[r] * li * g0); Y[row * 1024 + h * 64 + 32 + r32] = (bf16_t)f2bf(o1[r] * li * g1); }
}
__device__ __forceinline__ void phase_attn_prompt(const Args& A, int vb, int nvb) {
    const int lane = threadIdx.x & 63, gw = vb * 8 + (threadIdx.x >> 6), NGW = nvb * 8;
    constexpr int NTASK = 16 * 257;
    for (int k = 0; k * NGW < NTASK; ++k) { const int i = (k & 1) ? k * NGW + (NGW - 1 - gw) : k * NGW + gw;
        if (i < NTASK) { const int qi = 256 - i / 16, bh = i % 16; attn_task(A, bh >> 3, bh & 7, qi, lane); } }
}
__device__ __forceinline__ void sattn_unit(const Args& A, int u, int lane) {
    const int sb = u >> 4, pg = u & 15, h = lane >> 3, dl = (lane & 7) * 8;
    const bf16_t* QA = (const bf16_t*)(A.ws + WS_QA); const float* PSUM = (const float*)(A.ws + WS_PSUM);
    const int page = A.page_table[u];
    float q[4][8];
#pragma unroll
    for (int j = 0; j < 4; ++j) { const bf16x8 qv = *(const bf16x8*)(QA + (size_t)(MP + sb * 4 + j) * 512 + h * 64 + dl);
#pragma unroll
        for (int i = 0; i < 8; ++i) q[j][i] = bf2f((bf16_t)qv[i]); }
    float run = 0.f;
    for (int p2 = pg + 1; p2 < NPAGE; ++p2) run += PSUM[(size_t)(sb * NPAGE + p2) * 8 + h];
    float m[4], l[4], o[4][8];
#pragma unroll
    for (int j = 0; j < 4; ++j) { m[j] = -1e30f; l[j] = 0.f;
#pragma unroll
        for (int i = 0; i < 8; ++i) o[j][i] = 0.f; }
    const float* kb = A.cache_k + ((size_t)page * PAGE * 8 + h) * 64 + dl; const float* vb = A.cache_v + ((size_t)page * PAGE * 8 + h) * 64 + dl;
    const float* lfp = A.cache_logf + (size_t)page * PAGE * 8 + h;
#pragma unroll 4
    for (int t = PAGE - 1; t >= 0; --t) {
        const f32x4 k0 = *(const f32x4*)(kb + (size_t)t * 512), k1 = *(const f32x4*)(kb + (size_t)t * 512 + 4);
        const f32x4 v0 = *(const f32x4*)(vb + (size_t)t * 512), v1 = *(const f32x4*)(vb + (size_t)t * 512 + 4);
        const float lf = lfp[t * 8]; const float bias = run * LOG2E; run += lf;
        const float kk[8] = {k0.x, k0.y, k0.z, k0.w, k1.x, k1.y, k1.z, k1.w}; const float vv[8] = {v0.x, v0.y, v0.z, v0.w, v1.x, v1.y, v1.z, v1.w};
#pragma unroll
        for (int j = 0; j < 4; ++j) { float d = 0.f;
#pragma unroll
            for (int i = 0; i < 8; ++i) d += q[j][i] * kk[i];
            d += __shfl_xor(d, 1); d += __shfl_xor(d, 2); d += __shfl_xor(d, 4);
            const float s = d + bias, mn = fmaxf(m[j], s), a = fexp2(m[j] - mn), p = fexp2(s - mn); m[j] = mn; l[j] = l[j] * a + p;
#pragma unroll
            for (int i = 0; i < 8; ++i) o[j][i] = o[j][i] * a + p * vv[i]; }
    }
    float* PM = (float*)(A.ws + WS_PM); float* PL = (float*)(A.ws + WS_PL); float* PO = (float*)(A.ws + WS_PO);
#pragma unroll
    for (int j = 0; j < 4; ++j) { const size_t idx = ((size_t)u * 8 + h) * 4 + j; if ((lane & 7) == 0) { PM[idx] = m[j]; PL[idx] = l[j]; }
        *(f32x4*)(PO + idx * 64 + dl) = (f32x4){o[j][0], o[j][1], o[j][2], o[j][3]}; *(f32x4*)(PO + idx * 64 + dl + 4) = (f32x4){o[j][4], o[j][5], o[j][6], o[j][7]}; }
}
__device__ __forceinline__ void phase_sattn_part(const Args& A, int vb, int nvb) {
    const int lane = threadIdx.x & 63, gw = vb * 8 + (threadIdx.x >> 6), NGW = nvb * 8;
    for (int u = gw; u < NS * NPAGE; u += NGW) sattn_unit(A, u, lane);
}
__device__ __forceinline__ void phase_sattn_comb(const Args& A, int vb, int nvb) {
    const int lane = threadIdx.x & 63, gw = vb * 8 + (threadIdx.x >> 6), NGW = nvb * 8;
    const bf16_t* QA = (const bf16_t*)(A.ws + WS_QA); const bf16_t* KA = (const bf16_t*)(A.ws + WS_KA); const bf16_t* VA = (const bf16_t*)(A.ws + WS_VA); const bf16_t* GA = (const bf16_t*)(A.ws + WS_GA);
    const float* LFA = (const float*)(A.ws + WS_LFA); const float* PM = (const float*)(A.ws + WS_PM); const float* PL = (const float*)(A.ws + WS_PL); const float* PO = (const float*)(A.ws + WS_PO);
    bf16_t* Y = (bf16_t*)(A.ws + WS_Y);
    for (int t = gw; t < NS * AH; t += NGW) { const int sb = t >> 3, h = t & 7; const size_t row0 = (size_t)MP + sb * 4;
        float kd[4], vd[4], cn[4]; float c = 0.f;
#pragma unroll
        for (int j = 0; j < 4; ++j) { kd[j] = bf2f(KA[(row0 + j) * 512 + h * 64 + lane]); vd[j] = bf2f(VA[(row0 + j) * 512 + h * 64 + lane]); c += LFA[(row0 + j) * 8 + h]; cn[j] = c * LOG2E; }
#pragma unroll 1
        for (int j = 0; j < 4; ++j) { const float qd = bf2f(QA[(row0 + j) * 512 + h * 64 + lane]);
            float sn[4];
#pragma unroll
            for (int j2 = 0; j2 < 4; ++j2) sn[j2] = (j2 <= j) ? wave_sum(qd * kd[j2]) - cn[j2] : -1e30f;
            float mg[NPAGE], M = fmaxf(fmaxf(sn[0], sn[1]), fmaxf(sn[2], sn[3]));
#pragma unroll
            for (int g = 0; g < NPAGE; ++g) { mg[g] = PM[((size_t)(sb * NPAGE + g) * 8 + h) * 4 + j]; M = fmaxf(M, mg[g]); }
            float L = 0.f, O = 0.f;
#pragma unroll
            for (int g = 0; g < NPAGE; ++g) { const size_t idx = ((size_t)(sb * NPAGE + g) * 8 + h) * 4 + j; const float w = fexp2(mg[g] - M); L += w * PL[idx]; O += w * PO[idx * 64 + lane]; }
#pragma unroll
            for (int j2 = 0; j2 < 4; ++j2) { const float w = fexp2(sn[j2] - M); L += w; O += w * vd[j2]; }
            const float gate = bf2f(GA[(row0 + j) * 512 + h * 64 + lane]);
            Y[(row0 + j) * 1024 + h * 64 + lane] = (bf16_t)f2bf(O / L * gate); }
    }
}
template <int KSTEPS> __device__ __forceinline__ void mma_tile(f32x16& acc, const LAS bf16_t* Ap, int lda, const LAS bf16_t* Bp, int ldb, int lane) {
    const int r32 = lane & 31, hi = lane >> 5;
#pragma unroll
    for (int ks = 0; ks < KSTEPS; ++ks) { const bf16x8 a = *(const LAS bf16x8*)(Ap + r32 * lda + ks * 16 + hi * 8), b = *(const LAS bf16x8*)(Bp + r32 * ldb + ks * 16 + hi * 8);
        acc = __builtin_amdgcn_mfma_f32_32x32x16_bf16(a, b, acc, 0, 0, 0); }
}
constexpr int H_BS = 0, H_QT = 32768, H_KI = 50176, H_VT = 67584, H_ST = 86016, H_AB = 120832;
constexpr int LDQ = 136, LDV = 72;
__device__ __forceinline__ void hgrn_load_common(const Args& A, size_t r0, int h, LAS unsigned char* lds) {
    const int tid = threadIdx.x; const float* LFB = (const float*)(A.ws + WS_LFB); const bf16_t* VB = (const bf16_t*)(A.ws + WS_VB);
    LAS float* bs = (LAS float*)(lds + H_BS); LAS bf16_t* VT = (LAS bf16_t*)(lds + H_VT);
#pragma unroll
    for (int i = 0; i < 4; ++i) { const int idx = tid + NTHREADS * i, t = idx >> 5, k4 = (idx & 31) * 4; *(LAS f32x4*)(bs + t * 128 + k4) = *(const f32x4*)(LFB + (r0 + t) * 512 + h * 128 + k4); }
#pragma unroll
    for (int i = 0; i < 2; ++i) { const int idx = tid + NTHREADS * i, s = idx >> 4, v8 = (idx & 15) * 8; const bf16x8 vv = *(const bf16x8*)(VB + (r0 + s) * 512 + h * 128 + v8);
#pragma unroll
        for (int e = 0; e < 8; ++e) VT[(v8 + e) * LDV + s] = (bf16_t)vv[e]; }
    __syncthreads();
    if (tid < 128) { float run = 0.f;
        for (int t = 0; t < 64; ++t) { run += bs[t * 128 + tid]; bs[t * 128 + tid] = run; } }
    __syncthreads();
}
__device__ __forceinline__ void phase_hgrn1(const Args& A, int vb, int nvb, LAS unsigned char* lds) {
    const int tid = threadIdx.x, lane = tid & 63, wave = tid >> 6;
    const bf16_t* KB = (const bf16_t*)(A.ws + WS_KB); float* SLOC = (float*)(A.ws + WS_SLOC); float* DCH = (float*)(A.ws + WS_DCH);
    LAS float* bs = (LAS float*)(lds + H_BS); LAS bf16_t* VT = (LAS bf16_t*)(lds + H_VT); LAS bf16_t* KT = (LAS bf16_t*)(lds + H_QT);
    for (int u = vb; u < 8 * (NCH - 1); u += nvb) { const int bh = u / (NCH - 1), c = 1 + u % (NCH - 1), b = bh >> 2, h = bh & 3; const size_t r0 = (size_t)b * RB + 64 * c;
        hgrn_load_common(A, r0, h, lds);
#pragma unroll
        for (int i = 0; i < 2; ++i) { const int idx = tid + NTHREADS * i, t = idx >> 4, k8 = (idx & 15) * 8; const bf16x8 kk = *(const bf16x8*)(KB + (r0 + t) * 512 + h * 128 + k8);
#pragma unroll
            for (int e = 0; e < 8; ++e) KT[(k8 + e) * LDV + t] = (bf16_t)f2bf(bf2f((bf16_t)kk[e]) * __expf(bs[63 * 128 + k8 + e] - bs[t * 128 + k8 + e])); }
        if (tid < 128) DCH[(size_t)(bh * NCH + c) * 128 + tid] = __expf(bs[63 * 128 + tid]);
        __syncthreads();
#pragma unroll
        for (int i = 0; i < 2; ++i) { const int id = wave * 2 + i, mv = id >> 2, nk = id & 3; f32x16 acc;
#pragma unroll
            for (int r = 0; r < 16; ++r) acc[r] = 0.f;
            mma_tile<4>(acc, VT + mv * 32 * LDV, LDV, KT + nk * 32 * LDV, LDV, lane);
            float* dst = SLOC + (size_t)(bh * NCH + c) * 16384 + nk * 32 + (lane & 31);
#pragma unroll
            for (int r = 0; r < 16; ++r) dst[(size_t)(mv * 32 + crow(r, lane >> 5)) * 128] = acc[r]; }
        __syncthreads();
    }
}
__device__ __forceinline__ void phase_hgrn2(const Args& A, int vb, int nvb) {
    const float* __restrict__ SLOC = (const float*)(A.ws + WS_SLOC); const float* __restrict__ DCH = (const float*)(A.ws + WS_DCH); bf16_t* __restrict__ SST = (bf16_t*)(A.ws + WS_SST);
    for (int idx = vb * NTHREADS + threadIdx.x; idx < 8 * 16384; idx += nvb * NTHREADS) { const int bh = idx >> 14, e = idx & 16383, k = e & 127, v = e >> 7; float S = 0.f;
#pragma unroll 8
        for (int c = 1; c < NCH; ++c) { const size_t cb = (size_t)(bh * NCH + c); SST[cb * 16384 + e] = (bf16_t)f2bf(S); S = DCH[cb * 128 + k] * S + SLOC[cb * 16384 + e]; }
        A.out[OFF_PST + ((size_t)bh * 128 + k) * 128 + v] = S; }
}
__device__ __forceinline__ void phase_hgrn3(const Args& A, int vb, int nvb, LAS unsigned char* lds) {
    const int tid = threadIdx.x, lane = tid & 63, wave = tid >> 6;
    const bf16_t* QB = (const bf16_t*)(A.ws + WS_QB); const bf16_t* KB = (const bf16_t*)(A.ws + WS_KB); const bf16_t* GB = (const bf16_t*)(A.ws + WS_GB); const bf16_t* SST = (const bf16_t*)(A.ws + WS_SST);
    bf16_t* Y = (bf16_t*)(A.ws + WS_Y);
    LAS float* bs = (LAS float*)(lds + H_BS); LAS bf16_t* VT = (LAS bf16_t*)(lds + H_VT); LAS bf16_t* QT = (LAS bf16_t*)(lds + H_QT); LAS bf16_t* KI = (LAS bf16_t*)(lds + H_KI);
    LAS bf16_t* STs = (LAS bf16_t*)(lds + H_ST); LAS bf16_t* AB = (LAS bf16_t*)(lds + H_AB);
    for (int u = vb; u < 8 * (NCH - 1); u += nvb) { const int bh = u / (NCH - 1), c = 1 + u % (NCH - 1), b = bh >> 2, h = bh & 3; const size_t r0 = (size_t)b * RB + 64 * c;
#pragma unroll
        for (int i = 0; i < 4; ++i) { const int idx = tid + NTHREADS * i, v = idx >> 4, k8 = (idx & 15) * 8; *(LAS bf16x8*)(STs + v * LDQ + k8) = *(const bf16x8*)(SST + (size_t)(bh * NCH + c) * 16384 + v * 128 + k8); }
        hgrn_load_common(A, r0, h, lds);
#pragma unroll
        for (int i = 0; i < 2; ++i) { const int idx = tid + NTHREADS * i, t = idx >> 4, k8 = (idx & 15) * 8;
            const bf16x8 qq = *(const bf16x8*)(QB + (r0 + t) * 512 + h * 128 + k8), kk = *(const bf16x8*)(KB + (r0 + t) * 512 + h * 128 + k8);
            float qo[8], ko[8];
#pragma unroll
            for (int e = 0; e < 8; ++e) { const float bb = bs[t * 128 + k8 + e]; qo[e] = bf2f((bf16_t)qq[e]) * __expf(bb); ko[e] = bf2f((bf16_t)kk[e]) * __expf(-bb); }
            u32x4 wq, wk; wq.x = pk2(qo[0], qo[1]); wq.y = pk2(qo[2], qo[3]); wq.z = pk2(qo[4], qo[5]); wq.w = pk2(qo[6], qo[7]);
            wk.x = pk2(ko[0], ko[1]); wk.y = pk2(ko[2], ko[3]); wk.z = pk2(ko[4], ko[5]); wk.w = pk2(ko[6], ko[7]);
            *(LAS u32x4*)(QT + t * LDQ + k8) = wq; *(LAS u32x4*)(KI + t * LDQ + k8) = wk; }
        __syncthreads();
        if (wave < 4) { const int mt = wave >> 1, ns = wave & 1; f32x16 acc;
#pragma unroll
            for (int r = 0; r < 16; ++r) acc[r] = 0.f;
            if (!(mt == 0 && ns == 1)) mma_tile<8>(acc, QT + mt * 32 * LDQ, LDQ, KI + ns * 32 * LDQ, LDQ, lane);
            const int s = ns * 32 + (lane & 31);
#pragma unroll
            for (int r = 0; r < 16; ++r) { const int t = mt * 32 + crow(r, lane >> 5); AB[t * LDV + s] = (bf16_t)((s <= t) ? f2bf(acc[r]) : 0u); } }
        __syncthreads();
        {   const int mt = wave >> 2, nv = wave & 3; f32x16 acc;
#pragma unroll
            for (int r = 0; r < 16; ++r) acc[r] = 0.f;
            mma_tile<8>(acc, QT + mt * 32 * LDQ, LDQ, STs + nv * 32 * LDQ, LDQ, lane);
            mma_tile<4>(acc, AB + mt * 32 * LDV, LDV, VT + nv * 32 * LDV, LDV, lane);
#pragma unroll
            for (int r = 0; r < 16; ++r) bs[(mt * 32 + crow(r, lane >> 5)) * 128 + nv * 32 + (lane & 31)] = acc[r]; }
        __syncthreads();
        {   const int t = tid >> 3, seg = (tid & 7) * 16; float o[16], ss = 0.f;
#pragma unroll
            for (int i = 0; i < 16; ++i) { o[i] = bs[t * 128 + seg + i]; ss += o[i] * o[i]; }
            ss += __shfl_xor(ss, 1); ss += __shfl_xor(ss, 2); ss += __shfl_xor(ss, 4);
            const float rstd = 1.0f / sqrtf(ss * (1.0f / 128.0f) + RMS_EPS);
            unsigned w[8];
#pragma unroll
            for (int i = 0; i < 16; i += 2) { const float g0 = bf2f(GB[(r0 + t) * 512 + h * 128 + seg + i]) * A.out_norm[seg + i], g1 = bf2f(GB[(r0 + t) * 512 + h * 128 + seg + i + 1]) * A.out_norm[seg + i + 1];
                w[i >> 1] = pk2(o[i] * rstd * g0, o[i + 1] * rstd * g1); }
            u32x4* dst = (u32x4*)(Y + (r0 + t) * 1024 + 512 + h * 128 + seg); dst[0] = (u32x4){w[0], w[1], w[2], w[3]}; dst[1] = (u32x4){w[4], w[5], w[6], w[7]}; }
        __syncthreads();
    }
}
__device__ __forceinline__ void phase_hgrn_sample(const Args& A, int vb, int nvb, LAS unsigned char* lds) {
    const int tid = threadIdx.x, v = tid & 127, kg = tid >> 7;
    const bf16_t* QB = (const bf16_t*)(A.ws + WS_QB); const bf16_t* KB = (const bf16_t*)(A.ws + WS_KB); const bf16_t* VB = (const bf16_t*)(A.ws + WS_VB); const bf16_t* GB = (const bf16_t*)(A.ws + WS_GB);
    const float* LFB = (const float*)(A.ws + WS_LFB); bf16_t* Y = (bf16_t*)(A.ws + WS_Y);
    LAS float* sm = (LAS float*)lds;
    LAS float* red = sm + 4 * 3 * 128;
    LAS float* nrm = red + 4 * 4 * 128;
    for (int u = vb; u < NS * BH; u += nvb) { const int sb = u >> 2, h = u & 3; const size_t row0 = (size_t)MP + sb * 4;
        for (int i = tid; i < 4 * 128; i += NTHREADS) { const int j = i >> 7, k = i & 127; const size_t a = (row0 + j) * 512 + h * 128 + k;
            sm[(j * 3 + 0) * 128 + k] = __expf(LFB[a]); sm[(j * 3 + 1) * 128 + k] = bf2f(KB[a]); sm[(j * 3 + 2) * 128 + k] = bf2f(QB[a]); }
        float S[32]; const float* s0 = A.state_hgrn + ((size_t)u * 128 + kg * 32) * 128 + v;
#pragma unroll
        for (int i = 0; i < 32; ++i) S[i] = s0[(size_t)i * 128];
        float vv[4];
#pragma unroll
        for (int j = 0; j < 4; ++j) vv[j] = bf2f(VB[(row0 + j) * 512 + h * 128 + v]);
        __syncthreads();
#pragma unroll
        for (int j = 0; j < 4; ++j) { float part = 0.f;
#pragma unroll
            for (int i = 0; i < 32; ++i) { const int k = kg * 32 + i; S[i] = sm[(j * 3 + 0) * 128 + k] * S[i] + sm[(j * 3 + 1) * 128 + k] * vv[j]; part += sm[(j * 3 + 2) * 128 + k] * S[i]; }
            red[(j * 4 + kg) * 128 + v] = part; }
        float* s1 = A.out + OFF_SST + ((size_t)u * 128 + kg * 32) * 128 + v;
#pragma unroll
        for (int i = 0; i < 32; ++i) s1[(size_t)i * 128] = S[i];
        __syncthreads();
        const int j = kg; const float o = (red[(j * 4 + 0) * 128 + v] + red[(j * 4 + 1) * 128 + v]) + (red[(j * 4 + 2) * 128 + v] + red[(j * 4 + 3) * 128 + v]);
        const float ssq = wave_sum(o * o); if ((tid & 63) == 0) nrm[j * 2 + ((tid >> 6) & 1)] = ssq;
        __syncthreads();
        const float rstd = 1.0f / sqrtf((nrm[j * 2] + nrm[j * 2 + 1]) * (1.0f / 128.0f) + RMS_EPS);
        Y[(row0 + j) * 1024 + 512 + h * 128 + v] = (bf16_t)f2bf(o * rstd * A.out_norm[v] * bf2f(GB[(row0 + j) * 512 + h * 128 + v]));
        __syncthreads();
    }
}
__device__ __forceinline__ void phase_final(const Args& A, int vb, int nvb) {
    const int lane = threadIdx.x & 63, gw = vb * 8 + (threadIdx.x >> 6), NGW = nvb * 8;
    const float* TMP = (const float*)(A.ws + WS_TMP);
    f32x4 g[4];
#pragma unroll
    for (int j = 0; j < 4; ++j) g[j] = ((const f32x4*)A.post_norm)[lane + 64 * j];
    for (int r = gw; r < MT; r += NGW) { const float* xs; float* ys;
        if (r < MP) { const int b = r >= RB; const int p = r - b * RB; if (p < 128) continue; const size_t o = ((size_t)b * SEQ + (p - 128)) * 1024; xs = A.x_prompt + o; ys = A.out + OFF_YP + o; }
        else { const size_t o = (size_t)(r - MP) * 1024; xs = A.x_sample + o; ys = A.out + OFF_YS + o; }
        f32x4 t[4]; float ss = 0.f;
#pragma unroll
        for (int j = 0; j < 4; ++j) { t[j] = ((const f32x4*)(TMP + (size_t)r * 1024))[lane + 64 * j]; ss += (t[j].x * t[j].x + t[j].y * t[j].y) + (t[j].z * t[j].z + t[j].w * t[j].w); }
        ss = wave_sum(ss); const float rstd = 1.0f / sqrtf(ss * (1.0f / 1024.0f) + RMS_EPS);
#pragma unroll
        for (int j = 0; j < 4; ++j) { const f32x4 x = ((const f32x4*)xs)[lane + 64 * j]; ((f32x4*)ys)[lane + 64 * j] = x + t[j] * rstd * g[j]; }
    }
}

#define XB_TMO      128
#define XB_XCNT(j)  (256  + 64 * (j))
#define XB_XSUB(j)  (1280 + 64 * (j))
#define XB_XGEN(j)  (2304 + 64 * (j))
#define XB_TOP      3328
#define XB_TOPGEN   3392
#define XCD_BAR_WORDS 3456
#define XB_SPIN_CAP (1u << 18)

__device__ __forceinline__ unsigned xb_ld(unsigned* p)              { return __hip_atomic_load(p, __ATOMIC_RELAXED, __HIP_MEMORY_SCOPE_AGENT); }
__device__ __forceinline__ unsigned xb_add(unsigned* p, unsigned v) { return __hip_atomic_fetch_add(p, v, __ATOMIC_RELAXED, __HIP_MEMORY_SCOPE_AGENT); }
__device__ __forceinline__ unsigned xb_xcc_id() { return (unsigned)__builtin_amdgcn_s_getreg((3 << 11) | 20) & 0xFu; }
#define XB_SPIN(cond, bar) do { unsigned _sp = 0; while (cond) { __builtin_amdgcn_s_sleep(1); \
    if ((++_sp & 255u) == 0u) { if (xb_ld(&(bar)[XB_TMO])) break; if (_sp > XB_SPIN_CAP) { atomicAdd(&(bar)[XB_TMO], 1u); break; } } } } while (0)

struct XcdBarrier {
    unsigned* bar; unsigned x;
    volatile LAS unsigned* st;
};

__device__ __forceinline__ XcdBarrier xcd_barrier_post(unsigned* bar, volatile LAS unsigned* st) {
    XcdBarrier b; b.bar = bar; b.x = xb_xcc_id(); b.st = st;
    if (threadIdx.x == 0) (void)xb_add(&bar[XB_XCNT(b.x)], 1u);
    return b;
}
__device__ __forceinline__ void xcd_barrier_complete(unsigned* bar, unsigned x, unsigned& nloc, unsigned& nx) {
    const unsigned G = gridDim.x * gridDim.y * gridDim.z;
    unsigned sum, cnt, mine, sp = 0u;
    for (;;) {
        sum = 0u; cnt = 0u; mine = 0u;
#pragma unroll
        for (unsigned j = 0; j < 16; ++j) { const unsigned c = xb_ld(&bar[XB_XCNT(j)]); sum += c; cnt += (c > 0u) ? 1u : 0u; mine = (j == x) ? c : mine; }
        if (sum == G) break;
        __builtin_amdgcn_s_sleep(1);
        if ((++sp & 255u) == 0u) { if (xb_ld(&bar[XB_TMO])) break; if (sp > XB_SPIN_CAP) { atomicAdd(&bar[XB_TMO], 1u); break; } }
    }
    nloc = mine > 0u ? mine : 1u; nx = cnt > 0u ? cnt : 1u;
}

__device__ __forceinline__ void xcd_barrier(const XcdBarrier& b) {
    asm volatile("s_waitcnt vmcnt(0)" ::: "memory");
    __syncthreads();
    if (threadIdx.x == 0) {
        unsigned* bar = b.bar;
        __builtin_amdgcn_s_waitcnt(0);
        unsigned nloc = b.st[0], nx = b.st[1];
        if (nloc == 0u) { xcd_barrier_complete(bar, b.x, nloc, nx); b.st[0] = nloc; b.st[1] = nx; }
        const unsigned old = xb_add(&bar[XB_XSUB(b.x)], 1u);
        const unsigned gen = old / nloc;
        if (old + 1u == (gen + 1u) * nloc) {
            __builtin_amdgcn_fence(__ATOMIC_RELEASE, "agent");
            asm volatile("s_waitcnt vmcnt(0)" ::: "memory");
            const unsigned og = xb_add(&bar[XB_TOP], 1u);
            const unsigned tg = og / nx;
            if (og + 1u == (tg + 1u) * nx) xb_add(&bar[XB_TOPGEN], 1u);
            else XB_SPIN(xb_ld(&bar[XB_TOPGEN]) == tg, bar);
            __builtin_amdgcn_fence(__ATOMIC_ACQUIRE, "agent");
            xb_add(&bar[XB_XGEN(b.x)], 1u);
            asm volatile("s_waitcnt vmcnt(0)" ::: "memory");
        } else {
            XB_SPIN(xb_ld(&bar[XB_XGEN(b.x)]) == gen, bar);
            __builtin_amdgcn_fence(__ATOMIC_ACQUIRE, "agent");
            asm volatile("s_waitcnt vmcnt(0)" ::: "memory");
        }
    }
    __syncthreads();
}

constexpr int N_PHASES = 8;
__global__ void __launch_bounds__(NTHREADS, 2) fwd(Args A) {
    extern __shared__ __attribute__((aligned(16))) unsigned char lds_raw[];
    LAS unsigned char* lds = (LAS unsigned char*)lds_raw;
    const int G = gridDim.x, bx = blockIdx.x;
    const int vb = (G % 8 == 0) ? (bx % 8) * (G / 8) + bx / 8 : bx;
    const int lo = A.ph_lo, hi = A.ph_hi;
    LAS unsigned* xbw = (LAS unsigned*)(lds + LDS_BYTES - 64);
    if (threadIdx.x == 0) { xbw[0] = 0u; xbw[1] = 0u; }
    __syncthreads();
    XcdBarrier bar; bar.bar = (unsigned*)(A.ws + WS_CTL) + 4096; bar.x = 0; bar.st = nullptr;
    if (MK_FUSED) bar = xcd_barrier_post((unsigned*)(A.ws + WS_CTL) + 4096, (volatile LAS unsigned*)xbw);
#define SEAM(k) do { if (MK_FUSED && IN(k) && IN((k) + 1)) xcd_barrier(bar); } while (0)
#ifndef PHMASK
#define PHMASK 0xff
#endif
#define IN(k) (((PHMASK >> (k)) & 1) && lo <= (k) && (k) < hi)
    if (IN(0)) phase_prologue(A, vb, G, lds);
    SEAM(0);
    if (IN(1)) phase_cumsum(A, vb, G);
    SEAM(1);
    if (IN(2)) { pg8::Gemm g{(const pg8::bf16_t*)(A.ws + WS_HN), (const pg8::bf16_t*)(A.ws + WS_WIN), MT, 4096, 1024}; pg8::StaticOrder S; S.init(MT, 4096, G, bx);
        EpiIn E{A.ws, A.out, A.lb_raw}; pg8::gemm_phase<EpiIn, pg8::StaticOrder, true, true>(lds, g, S, E); }
    SEAM(2);
    if (IN(3)) { phase_attn_prompt(A, vb, G); phase_sattn_part(A, vb, G); __syncthreads(); phase_hgrn1(A, vb, G, lds); }
    SEAM(3);
    if (IN(4)) { phase_sattn_comb(A, vb, G); phase_hgrn2(A, vb, G); __syncthreads(); phase_hgrn_sample(A, vb, G, lds); }
    SEAM(4);
    if (IN(5)) phase_hgrn3(A, vb, G, lds);
    SEAM(5);
    if (IN(6)) { pg8::Gemm g{(const pg8::bf16_t*)(A.ws + WS_Y), (const pg8::bf16_t*)(A.ws + WS_WOUT), MT, 1024, 1024}; pg8::StaticOrder S; S.init(MT, 1024, G, bx);
        EpiOut E{(float*)(A.ws + WS_TMP)}; pg8::gemm_phase<EpiOut, pg8::StaticOrder, true, true>(lds, g, S, E); }
    SEAM(6);
    if (IN(7)) phase_final(A, vb, G);
#undef IN
#undef SEAM
}

extern "C" void kernel_launch(void* const* d_in, const int* in_sizes, int n_in, void* d_out, int out_size, void* d_ws, size_t ws_size, hipStream_t stream) {
    static int grid = 0;
    if (grid == 0) {
        if (n_in != 15 || out_size != (int)OUT_TOTAL || ws_size < WS_END) { fprintf(stderr, "kernel_launch: unexpected problem shape (n_in %d, out %d, ws %zu)\n", n_in, out_size, ws_size); grid = -1; return; }
        int dev = 0, cus = 0;
        if (hipGetDevice(&dev) != hipSuccess || hipDeviceGetAttribute(&cus, hipDeviceAttributeMultiprocessorCount, dev) != hipSuccess) { grid = -1; return; }
        if (hipFuncSetAttribute((const void*)fwd, hipFuncAttributeMaxDynamicSharedMemorySize, LDS_BYTES) != hipSuccess) { fprintf(stderr, "kernel_launch: hipFuncSetAttribute failed\n"); grid = -1; return; }
        int per_cu = 0;
        if (hipOccupancyMaxActiveBlocksPerMultiprocessor(&per_cu, (const void*)fwd, NTHREADS, LDS_BYTES) != hipSuccess || per_cu < 1) { fprintf(stderr, "kernel_launch: occupancy query reports %d workgroups per CU\n", per_cu); (void)hipGetLastError(); }
        grid = cus;
    }
    if (grid < 0) return;
    Args a{};
    a.x_prompt = (const float*)d_in[0]; a.x_sample = (const float*)d_in[1]; a.cache_k = (const float*)d_in[2]; a.cache_v = (const float*)d_in[3]; a.cache_logf = (const float*)d_in[4];
    a.state_hgrn = (const float*)d_in[5]; a.page_table = (const int*)d_in[6]; a.meta = (const float*)d_in[7]; a.w_in = (const float*)d_in[8]; a.b_forget = (const float*)d_in[9];
    a.lb_raw = (const float*)d_in[10]; a.out_norm = (const float*)d_in[11]; a.pre_norm = (const float*)d_in[12]; a.post_norm = (const float*)d_in[13]; a.w_out = (const float*)d_in[14];
    a.out = (float*)d_out; a.ws = (unsigned char*)d_ws;
    if (MK_FUSED) {
        if (hipMemsetAsync((char*)d_ws + WS_CTL, 0, CTL_BYTES, stream) != hipSuccess) { fprintf(stderr, "kernel_launch: memset failed\n"); return; }
        a.ph_lo = 0; a.ph_hi = N_PHASES; hipLaunchKernelGGL(fwd, dim3(grid), dim3(NTHREADS), LDS_BYTES, stream, a);
    } else
    for (int ph = 0; ph < N_PHASES; ++ph) { a.ph_lo = ph; a.ph_hi = ph + 1; hipLaunchKernelGGL(fwd, dim3(grid), dim3(NTHREADS), LDS_BYTES, stream, a); }
}
```

```cpp
#include <hip/hip_runtime.h>
#include <cstdio>
#include <cstdint>
#include <hip/hip_bf16.h>
namespace pg8 {
#define PG8_LAS __attribute__((address_space(3)))
typedef unsigned short bf16_t;
typedef short bf16x8 __attribute__((ext_vector_type(8)));
typedef float f32x4 __attribute__((ext_vector_type(4)));
typedef unsigned u32x4 __attribute__((ext_vector_type(4)));
constexpr int BM = 256, BK = 64, HALF = 128, HTB = HALF * BK * 2  , STAGE_BYTES = 8 * HTB, NXCD = 8, WGM = 8;

__host__ __device__ __forceinline__ int lds_byte(int r, int c) { const int st = (r >> 4) * 2 + (c >> 5), rr = r & 15, cc = c & 31, ob = rr * 64 + cc * 2; return st * 1024 + (ob ^ (((ob >> 9) & 1) << 5)); }
__host__ __device__ __forceinline__ void stage_rc(int b, int& R, int& C) { const int st = b / 1024, sb = b % 1024, swz = sb ^ (((sb >> 9) & 1) << 5); R = (st >> 1) * 16 + swz / 64; C = (st & 1) * 32 + (swz % 64) / 2; }
__host__ __device__ __forceinline__ int perm32(int rho) { const int n = rho >> 4, i = rho & 15; return 8 * (i >> 2) + 4 * n + (i & 3); }

struct Unit { int pm, pn; };
struct Gemm { const bf16_t* A; const bf16_t* Bt; int M, N, K; };

struct StaticOrder {
    int nM, nN, nwg, G, c;
    __host__ __device__ void init(int M, int N, int G_, int c_) { nM = M / BM; nN = N / BM; nwg = nM * nN; G = G_; c = c_; }
    __host__ __device__ bool next(int i, Unit& u) const {
        const long L = (long)i * G + c; if (L >= nwg) return false;
        int wgid = (int)L; { const int q = nwg / NXCD, r = nwg % NXCD, xcd = wgid % NXCD, off = wgid / NXCD; wgid = (xcd < r ? xcd * (q + 1) : r * (q + 1) + (xcd - r) * q) + off; }
        const int nig = WGM * nN, gid = wgid / nig, fm = gid * WGM, gsz = (nM - fm) < WGM ? (nM - fm) : WGM;
        u.pm = fm + ((wgid % nig) % gsz); u.pn = (wgid % nig) / gsz; return true;
    }
    __device__ __forceinline__ void a_ready(const Unit&) const {}
    __device__ __forceinline__ void done(const Unit&) const {}
};

__device__ __forceinline__ unsigned cvt_pk_bf16(float lo, float hi) { unsigned r; asm volatile("v_cvt_pk_bf16_f32 %0, %1, %2" : "=v"(r) : "v"(lo), "v"(hi)); return r; }
typedef float f32x2 __attribute__((ext_vector_type(2)));
template <class Epi, class Sched, bool ALIGN_EPI = false, bool SP2 = false>
__device__ __forceinline__ void gemm_phase(PG8_LAS unsigned char* lds, const Gemm g, const Sched& S, const Epi& E) {
    const int tid = threadIdx.x, wid = __builtin_amdgcn_readfirstlane(tid >> 6), lane = tid & 63, wr = wid >> 2, wc = wid & 3, fr = lane & 15, fq = lane >> 4;
    const int K = g.K, nt = K / BK;
    unsigned voffA[2], voffB[2];
#pragma unroll
    for (int i = 0; i < 2; ++i) { int R, C; stage_rc(tid * 16 + i * 8192, R, C); const int Rb = Epi::PERM ? ((R & ~31) + perm32(R & 31)) : R;
        voffA[i] = (unsigned)(R * K + C) * 2u; voffB[i] = (unsigned)(Rb * K + C) * 2u; }
    const size_t kstep = (size_t)(BK * 2);
    const size_t hstep = (size_t)HALF * K * 2;
    const size_t tstep = 2 * hstep;
    const unsigned ldsw = (unsigned)wid * 1024u;
    const int aoff = lds_byte(wr * 64 + fr, fq * 8), boff = lds_byte(wc * 32 + fr, fq * 8);
#define PG8_SA(b, h) (((b) * 2 + (h)) * HTB)
#define PG8_SB(b, h) ((4 + (b) * 2 + (h)) * HTB)
#define PG8_STAGE(bufoff, gbase, voff) do { _Pragma("unroll") for (int _i = 0; _i < 2; ++_i) \
        __builtin_amdgcn_global_load_lds((const unsigned*)((const char*)(gbase) + (voff)[_i]), (PG8_LAS unsigned*)(lds + (bufoff) + ldsw + _i * 8192), 16, 0, 0); } while (0)
#define PG8_LDA(dst, b, h) do { _Pragma("unroll") for (int m = 0; m < 4; ++m) _Pragma("unroll") for (int k = 0; k < 2; ++k) dst[m][k] = *(const PG8_LAS bf16x8*)(lds + PG8_SA(b, h) + aoff + m * 2048 + k * 1024); } while (0)
#define PG8_LDB(dst, b, h) do { _Pragma("unroll") for (int n = 0; n < 2; ++n) _Pragma("unroll") for (int k = 0; k < 2; ++k) dst[n][k] = *(const PG8_LAS bf16x8*)(lds + PG8_SB(b, h) + boff + n * 2048 + k * 1024); } while (0)
#define PG8_MMA(ai, bj, At, Bt) do { __builtin_amdgcn_s_setprio(1); _Pragma("unroll") for (int m = 0; m < 4; ++m) _Pragma("unroll") for (int n = 0; n < 2; ++n) _Pragma("unroll") for (int k = 0; k < 2; ++k) \
        acc[ai][bj][m][n] = __builtin_amdgcn_mfma_f32_16x16x32_bf16(Bt[n][k], At[m][k], acc[ai][bj][m][n], 0, 0, 0); __builtin_amdgcn_s_setprio(0); } while (0)
#define PG8_WAIT_V(n) asm volatile("s_waitcnt vmcnt(" #n ")" ::: "memory")
#define PG8_WAIT_L(n) asm volatile("s_waitcnt lgkmcnt(" #n ")" ::: "memory")
#define PG8_BAR __builtin_amdgcn_s_barrier()
#define PG8_SCHED __builtin_amdgcn_sched_barrier(0)
    Unit cur, nxt; int ui = 0;
    if (!S.next(0, cur)) return;
    f32x4 acc[2][2][4][2];
#pragma unroll
    for (int a = 0; a < 2; ++a)
#pragma unroll
        for (int b = 0; b < 2; ++b)
#pragma unroll
            for (int m = 0; m < 4; ++m)
#pragma unroll
                for (int n = 0; n < 2; ++n) acc[a][b][m][n] = (f32x4){0.f, 0.f, 0.f, 0.f};
    bf16x8 At[4][2], B0[2][2], B1[2][2];
    const char* cA = (const char*)g.A + (size_t)cur.pm * tstep; const char* cB = (const char*)g.Bt + (size_t)cur.pn * tstep;
    S.a_ready(cur);
    if constexpr (SP2) {
        PG8_STAGE(PG8_SB(0, 0), cB, voffB); PG8_STAGE(PG8_SB(0, 1), cB + hstep, voffB); PG8_STAGE(PG8_SA(0, 0), cA, voffA); PG8_STAGE(PG8_SA(0, 1), cA + hstep, voffA);
        if (wr == 1) PG8_BAR;
        PG8_WAIT_V(2); PG8_BAR;
        PG8_STAGE(PG8_SB(1, 0), cB + kstep, voffB); PG8_STAGE(PG8_SA(1, 0), cA + kstep, voffA); PG8_STAGE(PG8_SB(1, 1), cB + hstep + kstep, voffB);
        PG8_WAIT_V(6); PG8_BAR;
    } else {
        PG8_STAGE(PG8_SB(0, 0), cB, voffB); PG8_STAGE(PG8_SA(0, 0), cA, voffA); PG8_STAGE(PG8_SB(0, 1), cB + hstep, voffB); PG8_STAGE(PG8_SA(0, 1), cA + hstep, voffA);
        if (wr == 1) PG8_BAR;
        PG8_WAIT_V(4); PG8_BAR;
        PG8_STAGE(PG8_SB(1, 0), cB + kstep, voffB); PG8_STAGE(PG8_SA(1, 0), cA + kstep, voffA); PG8_STAGE(PG8_SB(1, 1), cB + hstep + kstep, voffB);
        PG8_WAIT_V(6); PG8_BAR;
    }
    for (;;) {
        const bool has_next = S.next(ui + 1, nxt);
        const char* nA = has_next ? (const char*)g.A + (size_t)nxt.pm * tstep : cA; const char* nB = has_next ? (const char*)g.Bt + (size_t)nxt.pn * tstep : cB;
        for (int t = 0; t < nt; t += 2) {
            const bool last = (t == nt - 2);
            const char* a1 = cA + (size_t)(t + 1) * kstep;
            const char* a2 = last ? nA : cA + (size_t)(t + 2) * kstep; const char* b2 = last ? nB : cB + (size_t)(t + 2) * kstep;
            const char* a3 = a2 + kstep; const char* b3 = b2 + kstep;
            if (last && has_next) S.a_ready(nxt);
            if constexpr (SP2) {
            PG8_LDB(B0, 0, 0); PG8_LDB(B1, 0, 1); PG8_SCHED; PG8_LDA(At, 0, 0); PG8_STAGE(PG8_SA(1, 1), a1 + hstep, voffA);
            PG8_WAIT_V(8); PG8_WAIT_L(0); PG8_BAR; PG8_MMA(0, 0, At, B0); PG8_MMA(0, 1, At, B1); PG8_BAR; PG8_SCHED;
            PG8_LDA(At, 0, 1); PG8_STAGE(PG8_SB(0, 0), b2, voffB); PG8_STAGE(PG8_SB(0, 1), b2 + hstep, voffB); PG8_STAGE(PG8_SA(0, 0), a2, voffA);
            PG8_WAIT_V(8); PG8_WAIT_L(0); PG8_BAR; PG8_MMA(1, 0, At, B0); PG8_MMA(1, 1, At, B1); PG8_BAR; PG8_SCHED;
            PG8_LDB(B0, 1, 0); PG8_LDB(B1, 1, 1); PG8_SCHED; PG8_LDA(At, 1, 0); PG8_STAGE(PG8_SA(0, 1), a2 + hstep, voffA);
            PG8_WAIT_V(8); PG8_WAIT_L(0); PG8_BAR; PG8_MMA(0, 0, At, B0); PG8_MMA(0, 1, At, B1); PG8_BAR; PG8_SCHED;
            PG8_LDA(At, 1, 1); PG8_STAGE(PG8_SB(1, 0), b3, voffB); PG8_STAGE(PG8_SB(1, 1), b3 + hstep, voffB); PG8_STAGE(PG8_SA(1, 0), a3, voffA);
            PG8_WAIT_V(8); PG8_WAIT_L(0); PG8_BAR; PG8_MMA(1, 0, At, B0); PG8_MMA(1, 1, At, B1); PG8_BAR; PG8_SCHED;
            } else {
            PG8_LDB(B0, 0, 0); PG8_SCHED; PG8_LDA(At, 0, 0); PG8_STAGE(PG8_SA(1, 1), a1 + hstep, voffA);
            PG8_WAIT_L(8); PG8_BAR; PG8_WAIT_L(0); PG8_MMA(0, 0, At, B0); PG8_BAR; PG8_SCHED;
            PG8_LDB(B1, 0, 1); PG8_STAGE(PG8_SB(0, 0), b2, voffB);
            PG8_BAR; PG8_WAIT_L(0); PG8_MMA(0, 1, At, B1); PG8_BAR;
            PG8_LDA(At, 0, 1); PG8_STAGE(PG8_SA(0, 0), a2, voffA);
            PG8_BAR; PG8_WAIT_L(0); PG8_MMA(1, 0, At, B0); PG8_BAR; PG8_SCHED;
            PG8_STAGE(PG8_SB(0, 1), b2 + hstep, voffB);
            PG8_WAIT_V(6); PG8_BAR; PG8_MMA(1, 1, At, B1); PG8_BAR;
            PG8_LDB(B0, 1, 0); PG8_SCHED; PG8_LDA(At, 1, 0); PG8_STAGE(PG8_SA(0, 1), a2 + hstep, voffA);
            PG8_WAIT_L(8); PG8_BAR; PG8_WAIT_L(0); PG8_MMA(0, 0, At, B0); PG8_BAR; PG8_SCHED;
            PG8_LDB(B1, 1, 1); PG8_STAGE(PG8_SB(1, 0), b3, voffB);
            PG8_BAR; PG8_WAIT_L(0); PG8_MMA(0, 1, At, B1); PG8_BAR;
            PG8_LDA(At, 1, 1); PG8_STAGE(PG8_SA(1, 0), a3, voffA);
            PG8_BAR; PG8_WAIT_L(0); PG8_MMA(1, 0, At, B0); PG8_BAR; PG8_SCHED;
            PG8_STAGE(PG8_SB(1, 1), b3 + hstep, voffB);
            PG8_WAIT_V(6); PG8_BAR; PG8_MMA(1, 1, At, B1); PG8_BAR;
            }
        }
        if constexpr (ALIGN_EPI) { if (wr == 0) PG8_BAR; }
        if constexpr (!Epi::AFTER_DRAIN) { E(acc, cur, wr, wc, fr, fq); S.done(cur); }
        if (!has_next) break;
#pragma unroll
        for (int a = 0; a < 2; ++a)
#pragma unroll
            for (int b = 0; b < 2; ++b)
#pragma unroll
                for (int m = 0; m < 4; ++m)
#pragma unroll
                    for (int n = 0; n < 2; ++n) acc[a][b][m][n] = (f32x4){0.f, 0.f, 0.f, 0.f};
        cur = nxt; cA = nA; cB = nB; ++ui;
        if constexpr (ALIGN_EPI) { if (wr == 1) PG8_BAR; }
    }
    PG8_WAIT_V(0);
    if constexpr (!ALIGN_EPI) { if (wr == 0) PG8_BAR; }
    PG8_BAR;
    if constexpr (Epi::AFTER_DRAIN) { E.fused(acc, cur, wr, wc, fr, fq, lds, wid, lane); S.done(cur); }
#undef PG8_SA
#undef PG8_SB
#undef PG8_STAGE
#undef PG8_LDA
#undef PG8_LDB
#undef PG8_MMA
#undef PG8_WAIT_V
#undef PG8_WAIT_L
#undef PG8_BAR
#undef PG8_SCHED
}
}

#ifndef MK_FUSED
#define MK_FUSED 1
#endif
#define LAS __attribute__((address_space(3)))
typedef unsigned short bf16_t;
typedef short bf16x8 __attribute__((ext_vector_type(8)));
typedef float f32x4 __attribute__((ext_vector_type(4)));
typedef float f32x16 __attribute__((ext_vector_type(16)));
typedef unsigned u32x4 __attribute__((ext_vector_type(4)));
typedef unsigned u32x2 __attribute__((ext_vector_type(2)));

constexpr int DMODEL = 1024, SEQ = 8192, NMETA = 16, LP = SEQ + NMETA;
constexpr int PADF = 112, RB = 8320;
constexpr int NBATCH = 2, MP = NBATCH * RB;
constexpr int NS = 128, ST = 4, MS = NS * ST;
constexpr int MT = MP + MS;
constexpr int AH = 8, AW = 512, BH = 4, BW = 512;
constexpr int INW = 4104, NPAGE = 16, PAGE = 128;
constexpr int NCH = 130;
constexpr float LOG2E = 1.4426950408889634f;
constexpr float QSCALE = 0.125f * LOG2E;
constexpr float RMS_EPS = 1e-6f;

constexpr size_t OFF_YP = 0, OFF_YS = OFF_YP + (size_t)NBATCH * SEQ * DMODEL, OFF_PK = OFF_YS + (size_t)MS * DMODEL, OFF_PV = OFF_PK + (size_t)NBATCH * LP * AW,
                 OFF_PLF = OFF_PV + (size_t)NBATCH * LP * AW, OFF_PST = OFF_PLF + (size_t)NBATCH * LP * AH, OFF_SK = OFF_PST + (size_t)NBATCH * BH * 128 * 128,
                 OFF_SV = OFF_SK + (size_t)MS * AW, OFF_SLF = OFF_SV + (size_t)MS * AW, OFF_SST = OFF_SLF + (size_t)MS * AH, OUT_TOTAL = OFF_SST + (size_t)NS * BH * 128 * 128;
static_assert(OUT_TOTAL == 43290880, "output size");

constexpr size_t MiB = 1u << 20;
constexpr size_t WS_CTL = 0, CTL_BYTES = 1 * MiB;
constexpr size_t WS_WIN = 1 * MiB;
constexpr size_t WS_WOUT = 9 * MiB;
constexpr size_t WS_HN = 12 * MiB;
constexpr size_t ACT = (size_t)MT * 512 * 2;
constexpr size_t WS_QA = 48 * MiB, WS_KA = WS_QA + 17 * MiB, WS_VA = WS_KA + 17 * MiB, WS_GA = WS_VA + 17 * MiB, WS_QB = WS_GA + 17 * MiB,
                 WS_KB = WS_QB + 17 * MiB, WS_VB = WS_KB + 17 * MiB, WS_GB = WS_VB + 17 * MiB;
constexpr size_t WS_LFB = 184 * MiB;
constexpr size_t WS_LFA = 218 * MiB;
constexpr size_t WS_CA = 219 * MiB;
constexpr size_t WS_PSUM = 220 * MiB;
constexpr size_t WS_PM = 221 * MiB, WS_PL = 222 * MiB;
constexpr size_t WS_PO = 223 * MiB;
constexpr size_t WS_DCH = 240 * MiB;
constexpr size_t WS_KX = 242 * MiB;
constexpr int CW_KNM = 16384, CW_QNU = 16448;
constexpr size_t WS_Y = 256 * MiB;
constexpr size_t WS_TMP = 292 * MiB;
constexpr size_t WS_SLOC = 360 * MiB;
constexpr size_t WS_SST = 428 * MiB;
constexpr size_t WS_END = 464 * MiB;
static_assert(ACT <= 17 * MiB && (size_t)MT * 1024 * 2 <= 36 * MiB && (size_t)MT * 1024 * 4 <= 68 * MiB && (size_t)8 * NCH * 16384 * 4 <= 68 * MiB, "ws map");

constexpr int LDS_BYTES = 147456;
constexpr int NTHREADS = 512;

struct Args {
    const float *x_prompt, *x_sample, *cache_k, *cache_v, *cache_logf, *state_hgrn; const int* page_table;
    const float *meta, *w_in, *b_forget, *lb_raw, *out_norm, *pre_norm, *post_norm, *w_out;
    float* out; unsigned char* ws; int ph_lo, ph_hi, li, pad;
};

__device__ __forceinline__ float bf2f(bf16_t v) { return __uint_as_float((unsigned)v << 16); }
__device__ __forceinline__ unsigned f2bf(float f) { unsigned u = __float_as_uint(f); return (u + 0x7fffu + ((u >> 16) & 1u)) >> 16; }
__device__ __forceinline__ unsigned pk2(float lo, float hi) { return f2bf(lo) | (f2bf(hi) << 16); }
__device__ __forceinline__ float wave_sum(float v) {
#pragma unroll
    for (int o = 1; o < 64; o <<= 1) v += __shfl_xor(v, o);
    return v;
}
__device__ __forceinline__ int wave_id() { int w = __builtin_amdgcn_readfirstlane((int)(threadIdx.x >> 6)); asm volatile("" : "+s"(w)); return w; }
__device__ __forceinline__ float fexp2(float x) { return __builtin_amdgcn_exp2f(x); }
__device__ __forceinline__ float silu(float x) { return x / (1.0f + __expf(-x)); }
__device__ __forceinline__ int crow(int r, int hi) { return (r & 3) + 8 * (r >> 2) + 4 * hi; }

struct EpiIn {
    static constexpr bool PERM = true, AFTER_DRAIN = false;
    unsigned char* ws; float* out; const float* lb_raw;
    __device__ __forceinline__ static float* kv_row(float* pk, float* sk, int row) {
        if (row >= MP) return sk + (size_t)(row - MP) * 512;
        const int b = row >= RB; const int p = row - b * RB; if (p < PADF) return nullptr;
        return pk + ((size_t)b * LP + (p - PADF)) * 512;
    }
    __device__ __forceinline__ void operator()(const pg8::f32x4 (&acc)[2][2][4][2], const pg8::Unit& u, int wr, int wc, int fr, int fq) const {
        const int sec = u.pn >> 1;
        const int row0 = u.pm * 256 + wr * 64 + fr;
        const int col0 = (u.pn & 1) * 256 + wc * 32 + 8 * fq;
        bf16_t* dst = (bf16_t*)(ws + WS_QA + (size_t)sec * 17 * MiB);
        if (sec == 0 || sec == 6) {
            const float sc = (sec == 0) ? QSCALE : 1.0f;
#pragma unroll
            for (int ai = 0; ai < 2; ++ai)
#pragma unroll
                for (int m = 0; m < 4; ++m) { const int row = row0 + ai * 128 + m * 16;
#pragma unroll
                    for (int bj = 0; bj < 2; ++bj) { const f32x4 v0 = acc[ai][bj][m][0] * sc, v1 = acc[ai][bj][m][1] * sc;
                        u32x4 w; w.x = pk2(v0[0], v0[1]); w.y = pk2(v0[2], v0[3]); w.z = pk2(v1[0], v1[1]); w.w = pk2(v1[2], v1[3]);
                        *(u32x4*)(dst + (size_t)row * 512 + col0 + bj * 128) = w; } }
        } else if (sec == 1 || sec == 2) {
            float* pk = out + (sec == 1 ? OFF_PK : OFF_PV); float* sk = out + (sec == 1 ? OFF_SK : OFF_SV);
#pragma unroll
            for (int ai = 0; ai < 2; ++ai)
#pragma unroll
                for (int m = 0; m < 4; ++m) { const int row = row0 + ai * 128 + m * 16; float* orow = kv_row(pk, sk, row);
#pragma unroll
                    for (int bj = 0; bj < 2; ++bj) { const f32x4 v0 = acc[ai][bj][m][0], v1 = acc[ai][bj][m][1];
                        u32x4 w; w.x = pk2(v0[0], v0[1]); w.y = pk2(v0[2], v0[3]); w.z = pk2(v1[0], v1[1]); w.w = pk2(v1[2], v1[3]);
                        *(u32x4*)(dst + (size_t)row * 512 + col0 + bj * 128) = w;
                        if (orow) { *(f32x4*)(orow + col0 + bj * 128) = v0; *(f32x4*)(orow + col0 + bj * 128 + 4) = v1; } } }
        } else if (sec == 5) {
            float oml[2][8];
#pragma unroll
            for (int bj = 0; bj < 2; ++bj)
#pragma unroll
                for (int e = 0; e < 8; ++e) { const int c = col0 + bj * 128 + e; const float a0 = lb_raw[c], a1 = lb_raw[512 + c]; oml[bj][e] = 1.0f / (1.0f + __expf(a0 - a1)); }
            float* lfb = (float*)(ws + WS_LFB);
#pragma unroll
            for (int ai = 0; ai < 2; ++ai)
#pragma unroll
                for (int m = 0; m < 4; ++m) { const int row = row0 + ai * 128 + m * 16;
                    bool padrow = false; if (row < MP) { const int p = row - (row >= RB ? RB : 0); padrow = p < PADF; }
#pragma unroll
                    for (int bj = 0; bj < 2; ++bj) { float kk[8], lg[8];
#pragma unroll
                        for (int e = 0; e < 8; ++e) { const float x = acc[ai][bj][m][e >> 2][e & 3]; float k1 = oml[bj][e] / (1.0f + __expf(x)); float l1 = __logf(1.0f - k1);
                            if (padrow) { k1 = 0.f; l1 = 0.f; } kk[e] = k1; lg[e] = l1; }
                        u32x4 w; w.x = pk2(kk[0], kk[1]); w.y = pk2(kk[2], kk[3]); w.z = pk2(kk[4], kk[5]); w.w = pk2(kk[6], kk[7]);
                        *(u32x4*)(dst + (size_t)row * 512 + col0 + bj * 128) = w;
                        *(f32x4*)(lfb + (size_t)row * 512 + col0 + bj * 128) = (f32x4){lg[0], lg[1], lg[2], lg[3]};
                        *(f32x4*)(lfb + (size_t)row * 512 + col0 + bj * 128 + 4) = (f32x4){lg[4], lg[5], lg[6], lg[7]}; } }
        } else {
#pragma unroll
            for (int ai = 0; ai < 2; ++ai)
#pragma unroll
                for (int m = 0; m < 4; ++m) { const int row = row0 + ai * 128 + m * 16;
#pragma unroll
                    for (int bj = 0; bj < 2; ++bj) { const f32x4 v0 = acc[ai][bj][m][0], v1 = acc[ai][bj][m][1];
                        u32x4 w; w.x = pk2(silu(v0[0]), silu(v0[1])); w.y = pk2(silu(v0[2]), silu(v0[3])); w.z = pk2(silu(v1[0]), silu(v1[1])); w.w = pk2(silu(v1[2]), silu(v1[3]));
                        *(u32x4*)(dst + (size_t)row * 512 + col0 + bj * 128) = w; } }
        }
    }
};
struct EpiOut {
    static constexpr bool PERM = true, AFTER_DRAIN = false;
    float* tmp;
    __device__ __forceinline__ void operator()(const pg8::f32x4 (&acc)[2][2][4][2], const pg8::Unit& u, int wr, int wc, int fr, int fq) const {
        const int row0 = u.pm * 256 + wr * 64 + fr, col0 = u.pn * 256 + wc * 32 + 8 * fq;
#pragma unroll
        for (int ai = 0; ai < 2; ++ai)
#pragma unroll
            for (int m = 0; m < 4; ++m) { float* rp = tmp + (size_t)(row0 + ai * 128 + m * 16) * 1024 + col0;
#pragma unroll
                for (int bj = 0; bj < 2; ++bj) { *(f32x4*)(rp + bj * 128) = acc[ai][bj][m][0]; *(f32x4*)(rp + bj * 128 + 4) = acc[ai][bj][m][1]; } }
    }
};

__device__ __forceinline__ void transpose_item(const float* W, int ldw, int c0, int nblk, bf16_t* WT, int K, int row_off, LAS float* scr, int item, int lane) {
    const int kb = item / nblk, nb = item % nblk, k0 = 64 * kb, n0 = 32 * nb;
#pragma unroll 8
    for (int i = 0; i < 32; ++i) { const int kk = 2 * i + (lane >> 5); scr[kk * 33 + (lane & 31)] = W[(size_t)(k0 + kk) * ldw + c0 + n0 + (lane & 31)]; }
    asm volatile("s_waitcnt lgkmcnt(0)" ::: "memory");
    const int c = lane & 7;
#pragma unroll
    for (int j = 0; j < 4; ++j) { const int n = (lane >> 3) + 8 * j; const LAS float* s = scr + (8 * c) * 33 + n;
        u32x4 o; o.x = pk2(s[0 * 33], s[1 * 33]); o.y = pk2(s[2 * 33], s[3 * 33]); o.z = pk2(s[4 * 33], s[5 * 33]); o.w = pk2(s[6 * 33], s[7 * 33]);
        *(u32x4*)(WT + (size_t)(row_off + n0 + n) * K + k0 + 8 * c) = o; }
    asm volatile("s_waitcnt lgkmcnt(0)" ::: "memory");
}
__device__ __forceinline__ void phase_prologue(const Args& A, int vb, int nvb, LAS unsigned char* lds) {
    const int tid = threadIdx.x, lane = tid & 63, wave = wave_id(), gw = vb * 8 + wave, NGW = nvb * 8;
    unsigned char* ws = A.ws;
    {   LAS float* scr = (LAS float*)(lds + wave * 8448);
        const int secoff[8] = {0, 512, 1024, 1544, 2056, 2568, 3080, 3592};
        bf16_t* WinT = (bf16_t*)(ws + WS_WIN); bf16_t* WoutT = (bf16_t*)(ws + WS_WOUT);
        for (int it = gw; it < 2048 + 512; it += NGW) {
            if (it < 2048) { const int s = it >> 8; int c0 = 0;
#pragma unroll
                for (int q = 0; q < 8; ++q) if (s == q) c0 = secoff[q];
                transpose_item(A.w_in, INW, c0, 16, WinT, 1024, s * 512, scr, it & 255, lane); }
            else transpose_item(A.w_out, 1024, 0, 32, WoutT, 1024, 0, scr, it - 2048, lane);
        }
    }
    LAS float* W8 = (LAS float*)(lds + 73728);
    for (int i = tid; i < 8192; i += NTHREADS) { const int h = i & 7, k = i >> 3; W8[h * 1024 + k] = A.w_in[(size_t)k * INW + 1536 + h]; }
    __syncthreads();
    {   f32x4 g[4];
#pragma unroll
        for (int j = 0; j < 4; ++j) g[j] = ((const f32x4*)A.pre_norm)[lane + 64 * j];
        bf16_t* HN = (bf16_t*)(ws + WS_HN); float* LFA = (float*)(ws + WS_LFA);
        const float bfv = A.b_forget[lane & 7];
        for (int r = gw; r < MT; r += NGW) {
            const float* src = nullptr; float* lf_out = nullptr;
            if (r < MP) { const int b = r >= RB; const int p = r - b * RB;
                if (p >= 128) src = A.x_prompt + ((size_t)b * SEQ + (p - 128)) * 1024; else if (p >= PADF) src = A.meta + (size_t)(p - PADF) * 1024;
                if (p >= PADF) lf_out = A.out + OFF_PLF + ((size_t)b * LP + (p - PADF)) * 8; }
            else { src = A.x_sample + (size_t)(r - MP) * 1024; lf_out = A.out + OFF_SLF + (size_t)(r - MP) * 8; }
            f32x4 v[4]; float ss = 0.f;
#pragma unroll
            for (int j = 0; j < 4; ++j) { v[j] = src ? ((const f32x4*)src)[lane + 64 * j] : (f32x4){0.f, 0.f, 0.f, 0.f}; ss += (v[j].x * v[j].x + v[j].y * v[j].y) + (v[j].z * v[j].z + v[j].w * v[j].w); }
            ss = wave_sum(ss); const float rstd = 1.0f / sqrtf(ss * (1.0f / 1024.0f) + RMS_EPS);
#pragma unroll
            for (int j = 0; j < 4; ++j) { v[j] = v[j] * rstd * g[j];
                u32x2 w; w.x = pk2(v[j].x, v[j].y); w.y = pk2(v[j].z, v[j].w); ((u32x2*)(HN + (size_t)r * 1024))[lane + 64 * j] = w; }
            float mine = 0.f;
#pragma unroll
            for (int h = 0; h < 8; ++h) { float a = 0.f;
#pragma unroll
                for (int j = 0; j < 4; ++j) { const f32x4 w = *(const LAS f32x4*)(W8 + h * 1024 + 4 * lane + 256 * j); a += (v[j].x * w.x + v[j].y * w.y) + (v[j].z * w.z + v[j].w * w.w); }
                a = wave_sum(a); if (lane == h) mine = a; }
            if (lane < 8) { const float x = mine + bfv; float lf = fminf(x, 0.f) - log1pf(__expf(-fabsf(x))); if (!src) lf = 0.f;
                LFA[(size_t)r * 8 + lane] = lf; if (lf_out) lf_out[lane] = lf; }
        }
    }
    {   float* PSUM = (float*)(ws + WS_PSUM);
        for (int u = gw; u < NS * NPAGE; u += NGW) { const int page = A.page_table[u]; const f32x4* src = (const f32x4*)(A.cache_logf + (size_t)page * 1024);
            f32x4 a = (src[lane] + src[lane + 64]) + (src[lane + 128] + src[lane + 192]);
#pragma unroll
            for (int o = 2; o < 64; o <<= 1) { a.x += __shfl_xor(a.x, o); a.y += __shfl_xor(a.y, o); a.z += __shfl_xor(a.z, o); a.w += __shfl_xor(a.w, o); }
            if (lane < 2) *(f32x4*)(PSUM + (size_t)u * 8 + 4 * lane) = a; }
    }
}
__device__ __forceinline__ void phase_cumsum(const Args& A, int vb, int nvb) {
    const int lane = threadIdx.x & 63, gw = vb * 8 + wave_id(), NGW = nvb * 8;
    const float* LFA = (const float*)(A.ws + WS_LFA); float* CA = (float*)(A.ws + WS_CA);
    for (int t = gw; t < NBATCH * AH; t += NGW) { const int b = t >> 3, h = t & 7; float run = 0.f;
        for (int p0 = 0; p0 < RB; p0 += 64) { const size_t idx = ((size_t)b * RB + p0 + lane) * 8 + h; float x = LFA[idx];
#pragma unroll
            for (int o = 1; o < 64; o <<= 1) { const float y = __shfl_up(x, o); if (lane >= o) x += y; }
            x += run; CA[idx] = x * LOG2E; run = __shfl(x, 63); } }
}
__device__ __forceinline__ void attn_task(const Args& A, int b, int h, int qi, int lane) {
    const bf16_t* QA = (const bf16_t*)(A.ws + WS_QA); const bf16_t* KA = (const bf16_t*)(A.ws + WS_KA); const bf16_t* VA = (const bf16_t*)(A.ws + WS_VA);
    const bf16_t* GA = (const bf16_t*)(A.ws + WS_GA); const float* CA = (const float*)(A.ws + WS_CA); bf16_t* Y = (bf16_t*)(A.ws + WS_Y);
    const int r32 = lane & 31, hi = lane >> 5;
    const size_t rowq0 = (size_t)b * RB + 96 + 32 * qi;
    bf16x8 qf[4];
#pragma unroll
    for (int d0 = 0; d0 < 4; ++d0) qf[d0] = *(const bf16x8*)(QA + (rowq0 + r32) * 512 + h * 64 + d0 * 16 + hi * 8);
    const int pq = 96 + 32 * qi + r32, pqe = pq > PADF ? pq : PADF;
    const float cq = CA[(rowq0 + r32) * 8 + h];
    float m = -1e30f, lh = 0.f; f32x16 o0, o1;
#pragma unroll
    for (int r = 0; r < 16; ++r) { o0[r] = 0.f; o1[r] = 0.f; }
    for (int kt = 0; kt <= qi; ++kt) {
        const size_t kr0 = (size_t)b * RB + 96 + 32 * kt;
        f32x16 s;
#pragma unroll
        for (int r = 0; r < 16; ++r) s[r] = 0.f;
#pragma unroll
        for (int d0 = 0; d0 < 4; ++d0) { const bf16x8 kf = *(const bf16x8*)(KA + (kr0 + r32) * 512 + h * 64 + d0 * 16 + hi * 8); s = __builtin_amdgcn_mfma_f32_32x32x16_bf16(kf, qf[d0], s, 0, 0, 0); }
        float rm = -1e30f;
#pragma unroll
        for (int r = 0; r < 16; ++r) { const int kv = crow(r, hi); const float ck = CA[(kr0 + kv) * 8 + h]; const int pk = 96 + 32 * kt + kv;
            float v = s[r] + (cq - ck); const bool ok = (pk >= PADF) && (pk <= pqe); v = ok ? v : -1e30f; s[r] = v; rm = fmaxf(rm, v); }
        rm = fmaxf(rm, __shfl_xor(rm, 32));
        const float mn = fmaxf(m, rm), alpha = fexp2(m - mn); m = mn;
        float ps = 0.f;
#pragma unroll
        for (int r = 0; r < 16; ++r) { const float p = fexp2(s[r] - mn); s[r] = p; ps += p; }
        lh = lh * alpha + ps;
#pragma unroll
        for (int r = 0; r < 16; ++r) { const float a = __shfl(alpha, crow(r, hi)); o0[r] *= a; o1[r] *= a; }
        u32x4 pw0, pw1;
        pw0.x = pk2(s[0], s[1]); pw0.y = pk2(s[2], s[3]); pw0.z = pk2(s[4], s[5]); pw0.w = pk2(s[6], s[7]);
        pw1.x = pk2(s[8], s[9]); pw1.y = pk2(s[10], s[11]); pw1.z = pk2(s[12], s[13]); pw1.w = pk2(s[14], s[15]);
        const bf16x8 pa0 = __builtin_bit_cast(bf16x8, pw0), pa1 = __builtin_bit_cast(bf16x8, pw1);
#pragma unroll
        for (int ss = 0; ss < 2; ++ss) {
            bf16x8 vf0, vf1;
#pragma unroll
            for (int j = 0; j < 8; ++j) { const int kv = 16 * ss + 8 * (j >> 2) + 4 * hi + (j & 3); const bf16_t* vp = VA + (kr0 + kv) * 512 + h * 64 + r32; vf0[j] = (short)vp[0]; vf1[j] = (short)vp[32]; }
            o0 = __builtin_amdgcn_mfma_f32_32x32x16_bf16(ss ? pa1 : pa0, vf0, o0, 0, 0, 0);
            o1 = __builtin_amdgcn_mfma_f32_32x32x16_bf16(ss ? pa1 : pa0, vf1, o1, 0, 0, 0);
        }
    }
    const float L = lh + __shfl_xor(lh, 32), linv = 1.0f / L;
#pragma unroll
    for (int r = 0; r < 16; ++r) { const int q = crow(r, hi); const float li = __shfl(linv, q); const size_t row = rowq0 + q;
        const float g0 = bf2f(GA[row * 512 + h * 64 + r32]), g1 = bf2f(GA[row * 512 + h * 64 + 32 + r32]);
        Y[row * 1024 + h * 64 + r32] = (bf16_t)f2bf(o0[r] * li * g0); Y[row * 1024 + h * 64 + 32 + r32] = (bf16_t)f2bf(o1[r] * li * g1); }
}
namespace fox_attn {
using bf16=__hip_bfloat16;
using bf16x8=__attribute__((ext_vector_type(8)))short;
using s16x4=__attribute__((ext_vector_type(4)))short;
using f32x16=__attribute__((ext_vector_type(16)))float;
using u32x4=__attribute__((ext_vector_type(4)))unsigned;
constexpr int D=64,DM=512,YP=1024,RBROWS=8320;
constexpr int NW=8,QBLK=32,QB=QBLK*NW,KVBLK=64;
constexpr int ATTN_PITCH=DM, ATTN_UNIT_ROWS=QB;
__device__ __forceinline__ int crow(int r,int hi){return (r&3)+8*(r>>2)+4*hi;}
#define SBAR() __builtin_amdgcn_sched_barrier(0)
__device__ __forceinline__ void cmask(f32x16&p0,f32x16&p1,int jb,int qrel,int hi){
  const float NEG=-INFINITY; int kb=64*jb+4*hi;
  #pragma unroll
  for(int r=0;r<16;++r){int kv=kb+(r&3)+8*(r>>2); if(kv>qrel)p0[r]=NEG; if(kv+32>qrel)p1[r]=NEG;}
}

constexpr int NSLOT=3, SLOTB=9216;
constexpr int LDS_K=0, LDS_V=NSLOT*SLOTB, LDS_WS=2*NSLOT*SLOTB, LDS_OST=LDS_WS+NW*64*4, LDS_BYTES=LDS_OST+NW*8192;
constexpr float C2=0.125f*1.4426950408889634f;
__device__ __forceinline__ void glds16(const void*gsrc,unsigned lds_dst){unsigned keep;
  asm volatile("s_mov_b32 %0, m0\n\ts_mov_b32 m0, %2\n\ts_nop 0\n\tglobal_load_lds_dwordx4 %1, off\n\ts_mov_b32 m0, %0":"=&s"(keep):"v"(gsrc),"s"(lds_dst):"memory");}
__device__ __forceinline__ void glds16s(const void*sbase,unsigned voff,unsigned lds_dst){unsigned keep;
  asm volatile("s_mov_b32 %0, m0\n\ts_mov_b32 m0, %3\n\ts_nop 0\n\tglobal_load_lds_dwordx4 %1, %2\n\ts_mov_b32 m0, %0":"=&s"(keep):"v"(voff),"s"(sbase),"s"(lds_dst):"memory");}
__device__ __forceinline__ float max3f(float a,float b,float c){float r;asm("v_max3_f32 %0, %1, %2, %3":"=v"(r):"v"(a),"v"(b),"v"(c));return r;}
__device__ __forceinline__ float max2f(float a,float b){float r;asm("v_max_f32_e32 %0, %1, %2":"=v"(r):"v"(a),"v"(b));return r;}
__device__ __forceinline__ float fadd_s(float a,float b){float r;asm("v_add_f32_e32 %0, %1, %2":"=v"(r):"v"(a),"v"(b));return r;}
__device__ __forceinline__ float fsub_s(float a,float b){float r;asm("v_sub_f32_e32 %0, %1, %2":"=v"(r):"v"(a),"v"(b));return r;}
typedef float f32x2_t __attribute__((ext_vector_type(2))); typedef float f32x4_t __attribute__((ext_vector_type(4))); typedef __bf16 bf16x2_t __attribute__((ext_vector_type(2)));
__device__ __forceinline__ unsigned cvtpk_s(float lo,float hi){f32x2_t v={lo,hi};bf16x2_t b=__builtin_convertvector(v,bf16x2_t);return __builtin_bit_cast(unsigned,b);}
#define WAIT_BAR(N) asm volatile("s_waitcnt vmcnt(" #N ") lgkmcnt(0)\n\ts_barrier":::"memory")

#define MFMA8(a,b,c) __builtin_amdgcn_mfma_f32_32x32x8bf16_1k(a,b,c,0,0,0)
__device__ __forceinline__ unsigned bf16r(float f){unsigned u=__float_as_uint(f);return (u+0x7fffu+((u>>16)&1u))>>16;}
__device__ __forceinline__ s16x4 setqx(float x,int hi){ const unsigned a=bf16r(x); const float r1=x-__uint_as_float(a<<16); const unsigned b2=bf16r(r1); const float r2=r1-__uint_as_float(b2<<16); const unsigned c3=bf16r(r2);
  s16x4 q; q[0]=(short)(hi?b2:0x3F80u); q[1]=(short)(hi?c3:0x3F80u); q[2]=(short)(hi?0u:0x3F80u); q[3]=(short)(hi?0u:a); return q; }
__device__ __forceinline__ void qkt(f32x16&p0,f32x16&p1,const char*Kslot,const bf16x8*qr,const s16x4 qx,int r32,int hi){
  const char*kb=Kslot+hi*1024+r32*16;
  { const s16x4 x0=*reinterpret_cast<const s16x4*>(Kslot+8192+r32*16+hi*8), x1=*reinterpret_cast<const s16x4*>(Kslot+8192+512+r32*16+hi*8); const f32x16 z=f32x16{}; p0=MFMA8(x0,qx,z); p1=MFMA8(x1,qx,z); }
  #pragma unroll
  for(int d0=0;d0<4;++d0){
    const bf16x8 b0=*reinterpret_cast<const bf16x8*>(kb+d0*2048);
    const bf16x8 b1=*reinterpret_cast<const bf16x8*>(kb+d0*2048+512);
    p0=__builtin_amdgcn_mfma_f32_32x32x16_bf16(b0,qr[d0],p0,0,0,0);p1=__builtin_amdgcn_mfma_f32_32x32x16_bf16(b1,qr[d0],p1,0,0,0);}
}
typedef __attribute__((address_space(3))) const char* lds_cptr;
typedef short v4i16_t __attribute__((ext_vector_type(4)));
__device__ __forceinline__ void kload8(bf16x8*kf,lds_cptr kp){
  kf[0]=*(const __attribute__((address_space(3))) bf16x8*)(kp);      kf[1]=*(const __attribute__((address_space(3))) bf16x8*)(kp+512);
  kf[2]=*(const __attribute__((address_space(3))) bf16x8*)(kp+2048); kf[3]=*(const __attribute__((address_space(3))) bf16x8*)(kp+2560);
  kf[4]=*(const __attribute__((address_space(3))) bf16x8*)(kp+4096); kf[5]=*(const __attribute__((address_space(3))) bf16x8*)(kp+4608);
  kf[6]=*(const __attribute__((address_space(3))) bf16x8*)(kp+6144); kf[7]=*(const __attribute__((address_space(3))) bf16x8*)(kp+6656);
}
__device__ __forceinline__ void kload2(bf16x8*kf,lds_cptr kp,int j){ kf[2*j]=*(const __attribute__((address_space(3))) bf16x8*)(kp+j*2048); kf[2*j+1]=*(const __attribute__((address_space(3))) bf16x8*)(kp+j*2048+512); }
__device__ __forceinline__ s16x4 vtr(lds_cptr p){ return __builtin_bit_cast(s16x4,__builtin_amdgcn_ds_read_tr16_b64_v4i16((__attribute__((address_space(3))) v4i16_t*)p)); }
__device__ __forceinline__ float rowmax(const f32x16&p0,const f32x16&p1){
  float a=max3f(p0[0],p0[1],p1[0]),b=max3f(p0[2],p0[3],p1[1]);a=max3f(a,p1[2],p1[3]);
  #pragma unroll
  for(int r=4;r<16;r+=4){a=max3f(a,p0[r],p0[r+1]);b=max3f(b,p0[r+2],p0[r+3]);a=max3f(a,p1[r],p1[r+1]);b=max3f(b,p1[r+2],p1[r+3]);}
  const float m=max2f(a,b);
  auto rr=__builtin_amdgcn_permlane32_swap(__float_as_uint(m),__float_as_uint(m),false,false);
  return max2f(__uint_as_float(rr[0]),__uint_as_float(rr[1]));
}
__device__ __forceinline__ void pv(f32x16*o,int vb,bf16x8 pa0,bf16x8 pa1,bf16x8 pa2,bf16x8 pa3){
  #pragma unroll
  for(int d0=0;d0<2;++d0){s16x4 lo[4],hi[4];
    #pragma unroll
    for(int ks=0;ks<4;++ks){
      asm volatile("ds_read_b64_tr_b16 %0,%1 offset:%c2":"=&v"(lo[ks]):"v"(vb),"i"(d0*4096+ks*1024):"memory");
      asm volatile("ds_read_b64_tr_b16 %0,%1 offset:%c2":"=&v"(hi[ks]):"v"(vb),"i"(d0*4096+ks*1024+512):"memory");}
    asm volatile("s_waitcnt lgkmcnt(0)":::"memory");SBAR();
    #define PK(k) (bf16x8){lo[k][0],lo[k][1],lo[k][2],lo[k][3],hi[k][0],hi[k][1],hi[k][2],hi[k][3]}
    o[d0]=__builtin_amdgcn_mfma_f32_32x32x16_bf16(pa0,PK(0),o[d0],0,0,0);
    o[d0]=__builtin_amdgcn_mfma_f32_32x32x16_bf16(pa1,PK(1),o[d0],0,0,0);
    o[d0]=__builtin_amdgcn_mfma_f32_32x32x16_bf16(pa2,PK(2),o[d0],0,0,0);
    o[d0]=__builtin_amdgcn_mfma_f32_32x32x16_bf16(pa3,PK(3),o[d0],0,0,0);
    #undef PK
  }
}

template<int THRL> __device__ __forceinline__ void attn_unit(int b,int h,int qb,int t0,const bf16*Q,const bf16*__restrict__ K,const bf16*__restrict__ V,const bf16*__restrict__ KX,const bf16*__restrict__ G,const float*__restrict__ CA,bf16*Y,char*shm){
  const int tid=threadIdx.x,lane=tid&63,r32=lane&31,hi=lane>>5; const int wid=__builtin_amdgcn_readfirstlane(tid>>6);
  const long rowbase=(long)b*RBROWS+(long)t0*KVBLK; const int q0=128+qb*QB-t0*KVBLK;
  const bf16*Qw=Q+(rowbase+q0+wid*QBLK)*DM+h*D;
  const bf16*Kh=K+rowbase*DM+h*D,*Vh=V+rowbase*DM+h*D;
  const unsigned lds0=(unsigned)(uintptr_t)shm;
  float*wsf=(float*)(shm+LDS_WS)+wid*64;
  const char*kbs=(const char*)(Kh+wid*8); const unsigned koff=(unsigned)lane*(DM*2);
  const char*kxbs=(const char*)(KX+(((long)(b*8+h))*RBROWS+(long)t0*KVBLK+wid*8)*8); const unsigned kxoff=(unsigned)(lane&7)*16;
  const char*vbs=(const char*)(Vh+(long)(16*(wid&3))*DM+(wid>>2)*32); const unsigned voff=(unsigned)((lane>>2)*DM+(lane&3)*8)*2;
  const unsigned kdst=lds0+LDS_K+wid*1024, vdst=lds0+LDS_V+wid*1024, kxdst=lds0+LDS_K+8192+wid*128;
  #define DMA_K(t,slot) do{ glds16s(kbs+(long)(t)*(KVBLK*DM*2),koff,(unsigned)__builtin_amdgcn_readfirstlane(kdst+(slot))); if(lane<8){glds16s(kxbs+(long)(t)*(KVBLK*16),kxoff,(unsigned)__builtin_amdgcn_readfirstlane(kxdst+(slot)));} }while(0)
  #define DMA_V(t,slot) glds16s(vbs+(long)(t)*(KVBLK*DM*2),voff,(unsigned)__builtin_amdgcn_readfirstlane(vdst+(slot)))
  const int vb0=(int)(lds0+LDS_V)+((lane>>4)&1)*32+(lane&3)*8+(4*hi+((lane&15)>>2))*64;
  const char*Kbase=shm+LDS_K; bf16x8 kf[8];
  const lds_cptr shm3=(lds_cptr)shm; const lds_cptr kp0=shm3+LDS_K+hi*1024+r32*16; const lds_cptr vp0=shm3+LDS_V+((lane>>4)&1)*32+(lane&3)*8+(4*hi+((lane&15)>>2))*64;
  const lds_cptr kxp0=shm3+LDS_K+8192+r32*16+hi*8;
  const int NT=(q0+QB)/KVBLK;
  DMA_K(0,0);DMA_V(0,0);DMA_K(1,SLOTB);
  bf16x8 qr[4];
  #pragma unroll
  for(int d0=0;d0<4;++d0)qr[d0]=*reinterpret_cast<const bf16x8*>(&Qw[(long)r32*DM+d0*16+hi*8]);
  const float cq=CA[((long)b*RBROWS+128+qb*QB+wid*QBLK+r32)*8+h];
  float mhat=-cq,l_reg=0.f;f32x16 o[2];o[0]=f32x16{};o[1]=f32x16{};
  s16x4 qx=setqx(cq,hi); s16x4 kx[2]; const f32x16 zero16=f32x16{};
  const int qrel=wid*QBLK+r32;
  #define CMASK(P0,P1,t) do{int jb_=(t)-(NT-4); if(jb_>=0)cmask(P0,P1,jb_,qrel,hi);}while(0)
  bool resc=false;
  #define START(P0,P1) do{ const float rm=rowmax(P0,P1); resc=false; \
    { const float dl=rm; mhat=fadd_s(mhat,dl); \
      _Pragma("unroll") for(int r=0;r<16;++r){P0[r]=fsub_s(P0[r],dl);P1[r]=fsub_s(P1[r],dl);} \
      qx=setqx(-mhat,hi); } \
    _Pragma("unroll") for(int r=0;r<16;++r)P0[r]=__builtin_amdgcn_exp2f(P0[r]); }while(0)
  #define RESC() do{ if(resc){ asm volatile("s_waitcnt lgkmcnt(0)":::"memory"); \
      _Pragma("unroll") for(int d_=0;d_<2;++d_) _Pragma("unroll") for(int r=0;r<16;++r)o[d_][r]*=wsf[crow(r,hi)]; } }while(0)
  f32x16 pA0,pA1,pB0,pB1;
  int sl_prev=0,sl_cur=0,sl_next=SLOTB;
  #define ROT() do{sl_prev=sl_cur;sl_cur=sl_next;sl_next=(sl_next==(NSLOT-1)*SLOTB)?0:sl_next+SLOTB;}while(0)
  DMA_K(2,2*SLOTB);
  WAIT_BAR(5);
  qkt(pA0,pA1,Kbase,qr,qx,r32,hi);asm volatile("s_nop 15\n\ts_nop 7":"+v"(pA0),"+v"(pA1));CMASK(pA0,pA1,0);
  START(pA0,pA1);
  _Pragma("unroll") for(int r=0;r<16;++r)pA1[r]=__builtin_amdgcn_exp2f(pA1[r]);
  WAIT_BAR(0);
  DMA_K(3,0);DMA_V(1,SLOTB);
  ROT();
  kload8(kf,kp0+sl_cur); kx[0]=*(const __attribute__((address_space(3))) s16x4*)(kxp0+sl_cur); kx[1]=*(const __attribute__((address_space(3))) s16x4*)(kxp0+sl_cur+512);
  WAIT_BAR(3);
  s16x4 vlo[8],vhi[8]; u32x4 pw0,pw1,pw2,pw3;
  #define PKW(P,B) cvtpk_s(P[B],P[B+1])
  #define PAF(k) __builtin_bit_cast(bf16x8,pw##k)
  #define VFR(i) (bf16x8){vlo[i][0],vlo[i][1],vlo[i][2],vlo[i][3],vhi[i][0],vhi[i][1],vhi[i][2],vhi[i][3]}
  #define PIN(x) asm volatile("":"+v"(x))
  #define MX3(a,b,c) __builtin_fmaxf(__builtin_fmaxf((a),(b)),(c))
  #define GAPA(MF,A0,A1,A2,A3,W0,W1,PW) do{ MF; sacc+=A0; sacc+=A1; sacc+=A2; sacc+=A3; PIN(sacc); W0; W1; PIN(PW); SBAR(); }while(0)
  #define EX(v) __builtin_amdgcn_exp2f(v)
  #define GAPB(MF,X,B) do{ MF; X[B]=EX(X[B]); X[B+1]=EX(X[B+1]); X[B+2]=EX(X[B+2]); X[B+3]=EX(X[B+3]); PIN(X); SBAR(); }while(0)
  #define VRD(i) do{ vlo[i]=vtr(vp_+(((i)>>2)*4096+((i)&3)*1024)); vhi[i]=vtr(vp_+(((i)>>2)*4096+((i)&3)*1024+512)); }while(0)
  #define KRD(G,j) do{ if(G){ kload2(kf,kp0+sl_next,j); if((j)==3){ kx[0]=*(const __attribute__((address_space(3))) s16x4*)(kxp0+sl_next); kx[1]=*(const __attribute__((address_space(3))) s16x4*)(kxp0+sl_next+512); } SBAR(); } }while(0)
  #define STEP(C0,C1,P0,P1,t,GK,GV,GL) do{ SBAR(); \
    const lds_cptr vp_=vp0+sl_prev; \
    C0=MFMA8(kx[0],qx,zero16); C1=MFMA8(kx[1],qx,zero16); SBAR(); \
    VRD(0); SBAR(); float sacc=(P0[0]+P0[1]); \
    GAPA(C0=__builtin_amdgcn_mfma_f32_32x32x16_bf16(kf[0],qr[0],C0,0,0,0), P0[2],P0[3],P0[4],P0[5],     pw0[0]=PKW(P0,0), pw0[1]=PKW(P0,2), pw0); \
    VRD(4); SBAR(); GAPA(C1=__builtin_amdgcn_mfma_f32_32x32x16_bf16(kf[1],qr[0],C1,0,0,0), P0[6],P0[7],P0[8],P0[9],     pw0[2]=PKW(P0,4), pw0[3]=PKW(P0,6), pw0); \
    VRD(1); SBAR(); GAPA(C0=__builtin_amdgcn_mfma_f32_32x32x16_bf16(kf[2],qr[1],C0,0,0,0),   P0[10],P0[11],P0[12],P0[13], pw1[0]=PKW(P0,8), pw1[1]=PKW(P0,10), pw1); \
    VRD(5); SBAR(); GAPA(C1=__builtin_amdgcn_mfma_f32_32x32x16_bf16(kf[3],qr[1],C1,0,0,0),   P0[14],P0[15],P1[0],P1[1],   pw1[2]=PKW(P0,12),pw1[3]=PKW(P0,14), pw1); \
    VRD(2); SBAR(); GAPA(C0=__builtin_amdgcn_mfma_f32_32x32x16_bf16(kf[4],qr[2],C0,0,0,0),   P1[2],P1[3],P1[4],P1[5],     pw2[0]=PKW(P1,0), pw2[1]=PKW(P1,2), pw2); \
    VRD(6); SBAR(); GAPA(C1=__builtin_amdgcn_mfma_f32_32x32x16_bf16(kf[5],qr[2],C1,0,0,0),   P1[6],P1[7],P1[8],P1[9],     pw2[2]=PKW(P1,4), pw2[3]=PKW(P1,6), pw2); \
    VRD(3); SBAR(); GAPA(C0=__builtin_amdgcn_mfma_f32_32x32x16_bf16(kf[6],qr[3],C0,0,0,0),   P1[10],P1[11],P1[12],P1[13], pw3[0]=PKW(P1,8), pw3[1]=PKW(P1,10), pw3); \
    VRD(7); SBAR(); GAPA(C1=__builtin_amdgcn_mfma_f32_32x32x16_bf16(kf[7],qr[3],C1,0,0,0),   P1[14],P1[15],0.f,0.f,       pw3[2]=PKW(P1,12),pw3[3]=PKW(P1,14), pw3); \
    l_reg+=sacc; \
    if(GK){DMA_K((t)+3,sl_cur);} if(GV){DMA_V((t)+1,sl_next);} \
    CMASK(C0,C1,t); \
    { float a=MX3(C0[0],C0[1],C1[0]),b=MX3(C0[2],C0[3],C1[1]); a=MX3(a,C1[2],C1[3]); \
      _Pragma("unroll") for(int r=4;r<16;r+=4){a=MX3(a,C0[r],C0[r+1]);b=MX3(b,C0[r+2],C0[r+3]);a=MX3(a,C1[r],C1[r+1]);b=MX3(b,C1[r+2],C1[r+3]);} \
      float rm=__builtin_fmaxf(a,b); { auto rr=__builtin_amdgcn_permlane32_swap(__float_as_uint(rm),__float_as_uint(rm),false,false); rm=__builtin_fmaxf(__uint_as_float(rr[0]),__uint_as_float(rr[1])); } \
      resc=false; \
      if(__builtin_expect(__any(rm>(float)THRL),0)){ const float dl=__builtin_fmaxf(rm,0.f); mhat+=dl; \
        _Pragma("unroll") for(int r=0;r<16;++r){C0[r]-=dl;C1[r]-=dl;} \
        qx=setqx(-mhat,hi); \
        const float f=__builtin_amdgcn_exp2f(-dl); l_reg*=f; if(hi==0)wsf[r32]=f; resc=true; } } \
    SBAR(); \
    GAPB(o[0]=__builtin_amdgcn_mfma_f32_32x32x16_bf16(PAF(0),VFR(0),o[0],0,0,0), C0,0); \
    GAPB(o[1]=__builtin_amdgcn_mfma_f32_32x32x16_bf16(PAF(0),VFR(4),o[1],0,0,0), C0,4); \
    KRD(GL,0); GAPB(o[0]=__builtin_amdgcn_mfma_f32_32x32x16_bf16(PAF(1),VFR(1),o[0],0,0,0), C0,8); \
    KRD(GL,1); GAPB(o[1]=__builtin_amdgcn_mfma_f32_32x32x16_bf16(PAF(1),VFR(5),o[1],0,0,0), C0,12); \
    KRD(GL,2); GAPB(o[0]=__builtin_amdgcn_mfma_f32_32x32x16_bf16(PAF(2),VFR(2),o[0],0,0,0), C1,0); \
    KRD(GL,3); GAPB(o[1]=__builtin_amdgcn_mfma_f32_32x32x16_bf16(PAF(2),VFR(6),o[1],0,0,0), C1,4); \
    GAPB(o[0]=__builtin_amdgcn_mfma_f32_32x32x16_bf16(PAF(3),VFR(3),o[0],0,0,0), C1,8); \
    GAPB(o[1]=__builtin_amdgcn_mfma_f32_32x32x16_bf16(PAF(3),VFR(7),o[1],0,0,0), C1,12); \
    }while(0)
  int t=1;
  #undef CMASK
  #define CMASK(P0,P1,t) do{}while(0)
  for(;t+5<NT;t+=2){
    STEP(pB0,pB1,pA0,pA1,t,true,true,true);     WAIT_BAR(3); RESC(); ROT();
    STEP(pA0,pA1,pB0,pB1,t+1,true,true,true);   WAIT_BAR(3); RESC(); ROT();
  }
  #undef CMASK
  #define CMASK(P0,P1,t) do{int jb_=(t)-(NT-4); if(jb_>=0)cmask(P0,P1,jb_,qrel,hi);}while(0)
  #define ENDW(tt) do{ if((tt)+3<NT){WAIT_BAR(3);} else if((tt)+2<NT){WAIT_BAR(1);} else {WAIT_BAR(0);} }while(0)
  for(;t+1<NT;t+=2){
    STEP(pB0,pB1,pA0,pA1,t,(t+3<NT),(t+1<NT),(t+1<NT));       ENDW(t);   RESC(); ROT();
    STEP(pA0,pA1,pB0,pB1,t+1,(t+4<NT),(t+2<NT),(t+2<NT));     ENDW(t+1); RESC(); ROT();
  }
  STEP(pB0,pB1,pA0,pA1,NT-1,false,false,false); RESC();
  { float sacc=pB0[0]+pB0[1]; _Pragma("unroll") for(int r=2;r<16;++r)sacc+=pB0[r]; _Pragma("unroll") for(int r=0;r<16;++r)sacc+=pB1[r]; l_reg+=sacc;
    pw0=(u32x4){PKW(pB0,0),PKW(pB0,2),PKW(pB0,4),PKW(pB0,6)};pw1=(u32x4){PKW(pB0,8),PKW(pB0,10),PKW(pB0,12),PKW(pB0,14)};pw2=(u32x4){PKW(pB1,0),PKW(pB1,2),PKW(pB1,4),PKW(pB1,6)};pw3=(u32x4){PKW(pB1,8),PKW(pB1,10),PKW(pB1,12),PKW(pB1,14)};
    SBAR(); pv(o,vb0+sl_cur,PAF(0),PAF(1),PAF(2),PAF(3)); }
  #undef PKW
  #undef PAF
  #undef VFR
  #undef PIN
  #undef MX3
  #undef GAPA
  #undef GAPB
  #undef EX
  #undef VRD
  #undef KRD
  #undef STEP
  #undef ENDW
  {auto rr=__builtin_amdgcn_permlane32_swap(__float_as_uint(l_reg),__float_as_uint(l_reg),false,false);l_reg=__uint_as_float(rr[0])+__uint_as_float(rr[1]);}
  if(hi==0)wsf[32+r32]=l_reg;asm volatile("s_waitcnt lgkmcnt(0)":::"memory");
  float rli[16];
  #pragma unroll
  for(int r=0;r<16;++r)rli[r]=__builtin_amdgcn_rcpf(wsf[32+crow(r,hi)]);
  const long orow0=(long)b*RBROWS+128+qb*QB+wid*QBLK;
  { float*stg=(float*)(shm+LDS_OST)+wid*2048;
    #pragma unroll
    for(int r=0;r<16;++r){const int orow=crow(r,hi);
      #pragma unroll
      for(int d0=0;d0<2;++d0)stg[orow*64+d0*32+r32]=o[d0][r]*rli[r];}
    asm volatile("s_waitcnt lgkmcnt(0)":::"memory");
    #pragma unroll
    for(int i=0;i<4;++i){const int row=i*8+(lane>>3),ch=lane&7; const f32x4_t a0=*(const f32x4_t*)(stg+row*64+ch*8), a1=*(const f32x4_t*)(stg+row*64+ch*8+4);
      const u32x4 gv=*(const u32x4*)(G+(orow0+row)*DM+h*D+ch*8); u32x4 w;
      w[0]=cvtpk_s(a0[0]*__uint_as_float(gv[0]<<16),a0[1]*__uint_as_float(gv[0]&0xffff0000u)); w[1]=cvtpk_s(a0[2]*__uint_as_float(gv[1]<<16),a0[3]*__uint_as_float(gv[1]&0xffff0000u));
      w[2]=cvtpk_s(a1[0]*__uint_as_float(gv[2]<<16),a1[1]*__uint_as_float(gv[2]&0xffff0000u)); w[3]=cvtpk_s(a1[2]*__uint_as_float(gv[3]<<16),a1[3]*__uint_as_float(gv[3]&0xffff0000u));
      *(u32x4*)(Y+(orow0+row)*YP+h*D+ch*8)=w;} }
  asm volatile("s_waitcnt lgkmcnt(0)\n\ts_barrier":::"memory");
  #undef DMA_K
  #undef DMA_V
  #undef CMASK
  #undef START
  #undef RESC
  #undef ROT
}
constexpr int ATTN_LDS_BYTES=LDS_BYTES;
#undef SBAR
#undef WAIT_BAR
#undef MFMA8
}

__device__ __forceinline__ void cumsum_job(const Args& A, int bh, LAS unsigned char* lds) {
    const int tid = threadIdx.x, lane = tid & 63, wave = wave_id(), b = bh >> 3, h = bh & 7;
    const float* LFA = (const float*)(A.ws + WS_LFA); float* CA = (float*)(A.ws + WS_CA); bf16_t* KX = (bf16_t*)(A.ws + WS_KX);
    LAS float* wtot = (LAS float*)lds;
    const int rbase = wave * 1040;
    float v[17];
#pragma unroll
    for (int i = 0; i < 17; ++i) { const int rr = 64 * i + lane; v[i] = (rr < 1040) ? LFA[((size_t)b * RB + rbase + rr) * 8 + h] : 0.f; }
    float run = 0.f;
#pragma unroll
    for (int i = 0; i < 17; ++i) { float x = v[i];
#pragma unroll
        for (int o = 1; o < 64; o <<= 1) { const float y = __shfl_up(x, o); if (lane >= o) x += y; }
        x += run; v[i] = x; run = __shfl(x, 63); }
    if (lane == 0) wtot[wave] = run;
    __syncthreads();
    float off = 0.f;
    for (int w = 0; w < wave; ++w) off += wtot[w];
#pragma unroll
    for (int i = 0; i < 17; ++i) { const int rr = 64 * i + lane;
        if (rr < 1040) { const int row = rbase + rr; const float c = (v[i] + off) * LOG2E; CA[((size_t)b * RB + row) * 8 + h] = c;
            const float x = (row < PADF) ? -30000.f : -c;
            const unsigned hi16 = f2bf(x); const float r1 = x - __uint_as_float(hi16 << 16); const unsigned mid16 = f2bf(r1); const float r2 = r1 - __uint_as_float(mid16 << 16); const unsigned lo16 = f2bf(r2);
            *(u32x4*)(KX + (((size_t)bh) * RB + row) * 8) = (u32x4){hi16 | (mid16 << 16), lo16 | 0x3F800000u, 0x3F803F80u, 0u}; } }
    __syncthreads();
}
__device__ __forceinline__ void phase_norms(const Args& A, int vb, int nvb) {
    const int lane = threadIdx.x & 63, gw = vb * 8 + wave_id(), NGW = nvb * 8;
    const bf16_t* QA = (const bf16_t*)(A.ws + WS_QA); const bf16_t* KA = (const bf16_t*)(A.ws + WS_KA); unsigned* ctl = (unsigned*)(A.ws + WS_CTL);
    for (int task = gw; task < NBATCH * (RB / 16); task += NGW) { const int b = task / (RB / 16), r0 = (task % (RB / 16)) * 16; float qm = 0.f, km = 0.f;
#pragma unroll 4
        for (int i = 0; i < 16; ++i) { const size_t row = (size_t)b * RB + r0 + i; const bf16x8 qv = *(const bf16x8*)(QA + row * 512 + lane * 8), kv = *(const bf16x8*)(KA + row * 512 + lane * 8);
            float sq = 0.f, sk = 0.f;
#pragma unroll
            for (int e = 0; e < 8; ++e) { const float q = bf2f((bf16_t)qv[e]), k = bf2f((bf16_t)kv[e]); sq += q * q; sk += k * k; }
            sq += __shfl_xor(sq, 1); sq += __shfl_xor(sq, 2); sq += __shfl_xor(sq, 4); sk += __shfl_xor(sk, 1); sk += __shfl_xor(sk, 2); sk += __shfl_xor(sk, 4);
            qm = fmaxf(qm, sq); km = fmaxf(km, sk); }
        if ((lane & 7) == 0) { const int h = lane >> 3;
            __hip_atomic_fetch_max(ctl + CW_KNM + b * 8 + h, __float_as_uint(sqrtf(km) * 1.001f), __ATOMIC_RELAXED, __HIP_MEMORY_SCOPE_AGENT);
            if (r0 >= 128) __hip_atomic_fetch_max(ctl + CW_QNU + (b * 8 + h) * 32 + (r0 - 128) / 256, __float_as_uint(sqrtf(qm) * 1.001f), __ATOMIC_RELAXED, __HIP_MEMORY_SCOPE_AGENT); }
    }
}
__device__ __forceinline__ void phase_attn_units(const Args& A, int vb, int nvb, unsigned char* lds_generic) {
    const int lane = threadIdx.x & 63;
    const float* CA = (const float*)(A.ws + WS_CA); const unsigned* ctl = (const unsigned*)(A.ws + WS_CTL);
    for (int u = vb; u < 512; u += nvb) { const int bh = u >> 5, qb = u & 31, b = bh >> 3, h = bh & 7;
        const float qn = __uint_as_float(ctl[CW_QNU + bh * 32 + qb]), kn = __uint_as_float(ctl[CW_KNM + bh]);
        const float th = -(2.0f * qn * kn + 40.0f);
        const int NTF = 6 + 4 * qb; const size_t rb = (size_t)b * RB;
        const float cq0 = CA[(rb + 128 + 256 * qb) * 8 + h];
        int cnt = 0;
        for (int base = 0; base < NTF - 6; base += 64) { const int t = base + lane; bool ok = false; if (t < NTF - 6) ok = (cq0 - CA[(rb + 64 * t + 63) * 8 + h]) <= th; cnt += __popcll(__ballot(ok)); }
        const int t0 = __builtin_amdgcn_readfirstlane(cnt & ~1);
        fox_attn::attn_unit<8>(b, h, qb, t0, (const fox_attn::bf16*)(A.ws + WS_QA), (const fox_attn::bf16*)(A.ws + WS_KA), (const fox_attn::bf16*)(A.ws + WS_VA), (const fox_attn::bf16*)(A.ws + WS_KX),
                               (const fox_attn::bf16*)(A.ws + WS_GA), CA, (fox_attn::bf16*)(A.ws + WS_Y), (char*)lds_generic);
    }
    const int gw = vb * 8 + wave_id();
    if (gw < 16) attn_task(A, gw >> 3, gw & 7, 0, lane);
}
__device__ __forceinline__ void sattn_unit(const Args& A, int u, int lane) {
    const int sb = u >> 4, pg = u & 15, h = lane >> 3, dl = (lane & 7) * 8;
    const bf16_t* QA = (const bf16_t*)(A.ws + WS_QA); const float* PSUM = (const float*)(A.ws + WS_PSUM);
    const int page = A.page_table[u];
    float q[4][8];
#pragma unroll
    for (int j = 0; j < 4; ++j) { const bf16x8 qv = *(const bf16x8*)(QA + (size_t)(MP + sb * 4 + j) * 512 + h * 64 + dl);
#pragma unroll
        for (int i = 0; i < 8; ++i) q[j][i] = bf2f((bf16_t)qv[i]); }
    float run = 0.f;
    for (int p2 = pg + 1; p2 < NPAGE; ++p2) run += PSUM[(size_t)(sb * NPAGE + p2) * 8 + h];
    float m[4], l[4], o[4][8];
#pragma unroll
    for (int j = 0; j < 4; ++j) { m[j] = -1e30f; l[j] = 0.f;
#pragma unroll
        for (int i = 0; i < 8; ++i) o[j][i] = 0.f; }
    const float* kb = A.cache_k + ((size_t)page * PAGE * 8 + h) * 64 + dl; const float* vb = A.cache_v + ((size_t)page * PAGE * 8 + h) * 64 + dl;
    const float* lfp = A.cache_logf + (size_t)page * PAGE * 8 + h;
#pragma unroll 4
    for (int t = PAGE - 1; t >= 0; --t) {
        const f32x4 k0 = *(const f32x4*)(kb + (size_t)t * 512), k1 = *(const f32x4*)(kb + (size_t)t * 512 + 4);
        const f32x4 v0 = *(const f32x4*)(vb + (size_t)t * 512), v1 = *(const f32x4*)(vb + (size_t)t * 512 + 4);
        const float lf = lfp[t * 8]; const float bias = run * LOG2E; run += lf;
        const float kk[8] = {k0.x, k0.y, k0.z, k0.w, k1.x, k1.y, k1.z, k1.w}; const float vv[8] = {v0.x, v0.y, v0.z, v0.w, v1.x, v1.y, v1.z, v1.w};
#pragma unroll
        for (int j = 0; j < 4; ++j) { float d = 0.f;
#pragma unroll
            for (int i = 0; i < 8; ++i) d += q[j][i] * kk[i];
            d += __shfl_xor(d, 1); d += __shfl_xor(d, 2); d += __shfl_xor(d, 4);
            const float s = d + bias, mn = fmaxf(m[j], s), a = fexp2(m[j] - mn), p = fexp2(s - mn); m[j] = mn; l[j] = l[j] * a + p;
#pragma unroll
            for (int i = 0; i < 8; ++i) o[j][i] = o[j][i] * a + p * vv[i]; }
    }
    float* PM = (float*)(A.ws + WS_PM); float* PL = (float*)(A.ws + WS_PL); float* PO = (float*)(A.ws + WS_PO);
#pragma unroll
    for (int j = 0; j < 4; ++j) { const size_t idx = ((size_t)u * 8 + h) * 4 + j; if ((lane & 7) == 0) { PM[idx] = m[j]; PL[idx] = l[j]; }
        *(f32x4*)(PO + idx * 64 + dl) = (f32x4){o[j][0], o[j][1], o[j][2], o[j][3]}; *(f32x4*)(PO + idx * 64 + dl + 4) = (f32x4){o[j][4], o[j][5], o[j][6], o[j][7]}; }
}
__device__ __forceinline__ void phase_sattn_part(const Args& A, int vb, int nvb) {
    const int lane = threadIdx.x & 63, gw = vb * 8 + wave_id(), NGW = nvb * 8;
    for (int u = gw; u < NS * NPAGE; u += NGW) sattn_unit(A, u, lane);
}
__device__ __forceinline__ void phase_sattn_comb(const Args& A, int vb, int nvb) {
    const int lane = threadIdx.x & 63, gw = vb * 8 + wave_id(), NGW = nvb * 8;
    const bf16_t* QA = (const bf16_t*)(A.ws + WS_QA); const bf16_t* KA = (const bf16_t*)(A.ws + WS_KA); const bf16_t* VA = (const bf16_t*)(A.ws + WS_VA); const bf16_t* GA = (const bf16_t*)(A.ws + WS_GA);
    const float* LFA = (const float*)(A.ws + WS_LFA); const float* PM = (const float*)(A.ws + WS_PM); const float* PL = (const float*)(A.ws + WS_PL); const float* PO = (const float*)(A.ws + WS_PO);
    bf16_t* Y = (bf16_t*)(A.ws + WS_Y);
    for (int t = gw; t < NS * AH; t += NGW) { const int sb = t >> 3, h = t & 7; const size_t row0 = (size_t)MP + sb * 4;
        float kd[4], vd[4], cn[4]; float c = 0.f;
#pragma unroll
        for (int j = 0; j < 4; ++j) { kd[j] = bf2f(KA[(row0 + j) * 512 + h * 64 + lane]); vd[j] = bf2f(VA[(row0 + j) * 512 + h * 64 + lane]); c += LFA[(row0 + j) * 8 + h]; cn[j] = c * LOG2E; }
#pragma unroll 1
        for (int j = 0; j < 4; ++j) { const float qd = bf2f(QA[(row0 + j) * 512 + h * 64 + lane]);
            float sn[4];
#pragma unroll
            for (int j2 = 0; j2 < 4; ++j2) sn[j2] = (j2 <= j) ? wave_sum(qd * kd[j2]) - cn[j2] : -1e30f;
            float mg[NPAGE], M = fmaxf(fmaxf(sn[0], sn[1]), fmaxf(sn[2], sn[3]));
#pragma unroll
            for (int g = 0; g < NPAGE; ++g) { mg[g] = PM[((size_t)(sb * NPAGE + g) * 8 + h) * 4 + j]; M = fmaxf(M, mg[g]); }
            float L = 0.f, O = 0.f;
#pragma unroll
            for (int g = 0; g < NPAGE; ++g) { const size_t idx = ((size_t)(sb * NPAGE + g) * 8 + h) * 4 + j; const float w = fexp2(mg[g] - M); L += w * PL[idx]; O += w * PO[idx * 64 + lane]; }
#pragma unroll
            for (int j2 = 0; j2 < 4; ++j2) { const float w = fexp2(sn[j2] - M); L += w; O += w * vd[j2]; }
            const float gate = bf2f(GA[(row0 + j) * 512 + h * 64 + lane]);
            Y[(row0 + j) * 1024 + h * 64 + lane] = (bf16_t)f2bf(O / L * gate); }
    }
}
template <int KSTEPS> __device__ __forceinline__ void mma_tile(f32x16& acc, const LAS bf16_t* Ap, int lda, const LAS bf16_t* Bp, int ldb, int lane) {
    const int r32 = lane & 31, hi = lane >> 5;
#pragma unroll
    for (int ks = 0; ks < KSTEPS; ++ks) { const bf16x8 a = *(const LAS bf16x8*)(Ap + r32 * lda + ks * 16 + hi * 8), b = *(const LAS bf16x8*)(Bp + r32 * ldb + ks * 16 + hi * 8);
        acc = __builtin_amdgcn_mfma_f32_32x32x16_bf16(a, b, acc, 0, 0, 0); }
}
constexpr int H_BS = 0, H_QT = 32768, H_KI = 50176, H_VT = 67584, H_ST = 86016, H_AB = 120832;
constexpr int LDQ = 136, LDV = 72;
__device__ __forceinline__ void hgrn_load_common(const Args& A, size_t r0, int h, LAS unsigned char* lds) {
    const int tid = threadIdx.x; const float* LFB = (const float*)(A.ws + WS_LFB); const bf16_t* VB = (const bf16_t*)(A.ws + WS_VB);
    LAS float* bs = (LAS float*)(lds + H_BS); LAS bf16_t* VT = (LAS bf16_t*)(lds + H_VT);
#pragma unroll
    for (int i = 0; i < 4; ++i) { const int idx = tid + NTHREADS * i, t = idx >> 5, k4 = (idx & 31) * 4; *(LAS f32x4*)(bs + t * 128 + k4) = *(const f32x4*)(LFB + (r0 + t) * 512 + h * 128 + k4); }
#pragma unroll
    for (int i = 0; i < 2; ++i) { const int idx = tid + NTHREADS * i, s = idx >> 4, v8 = (idx & 15) * 8; const bf16x8 vv = *(const bf16x8*)(VB + (r0 + s) * 512 + h * 128 + v8);
#pragma unroll
        for (int e = 0; e < 8; ++e) VT[(v8 + e) * LDV + s] = (bf16_t)vv[e]; }
    __syncthreads();
    if (tid < 128) { float run = 0.f;
        for (int t = 0; t < 64; ++t) { run += bs[t * 128 + tid]; bs[t * 128 + tid] = run; } }
    __syncthreads();
}
__device__ __forceinline__ void phase_hgrn1(const Args& A, int vb, int nvb, LAS unsigned char* lds) {
    const int tid = threadIdx.x, lane = tid & 63, wave = wave_id();
    const bf16_t* KB = (const bf16_t*)(A.ws + WS_KB); float* SLOC = (float*)(A.ws + WS_SLOC); float* DCH = (float*)(A.ws + WS_DCH);
    LAS float* bs = (LAS float*)(lds + H_BS); LAS bf16_t* VT = (LAS bf16_t*)(lds + H_VT); LAS bf16_t* KT = (LAS bf16_t*)(lds + H_QT);
    for (int u = vb; u < 8 * (NCH - 1); u += nvb) { const int bh = u / (NCH - 1), c = 1 + u % (NCH - 1), b = bh >> 2, h = bh & 3; const size_t r0 = (size_t)b * RB + 64 * c;
        hgrn_load_common(A, r0, h, lds);
#pragma unroll
        for (int i = 0; i < 2; ++i) { const int idx = tid + NTHREADS * i, t = idx >> 4, k8 = (idx & 15) * 8; const bf16x8 kk = *(const bf16x8*)(KB + (r0 + t) * 512 + h * 128 + k8);
#pragma unroll
            for (int e = 0; e < 8; ++e) KT[(k8 + e) * LDV + t] = (bf16_t)f2bf(bf2f((bf16_t)kk[e]) * __expf(bs[63 * 128 + k8 + e] - bs[t * 128 + k8 + e])); }
        if (tid < 128) DCH[(size_t)(bh * NCH + c) * 128 + tid] = __expf(bs[63 * 128 + tid]);
        __syncthreads();
#pragma unroll
        for (int i = 0; i < 2; ++i) { const int id = wave * 2 + i, mv = id >> 2, nk = id & 3; f32x16 acc;
#pragma unroll
            for (int r = 0; r < 16; ++r) acc[r] = 0.f;
            mma_tile<4>(acc, VT + mv * 32 * LDV, LDV, KT + nk * 32 * LDV, LDV, lane);
            float* dst = SLOC + (size_t)(bh * NCH + c) * 16384 + nk * 32 + (lane & 31);
#pragma unroll
            for (int r = 0; r < 16; ++r) dst[(size_t)(mv * 32 + crow(r, lane >> 5)) * 128] = acc[r]; }
        __syncthreads();
    }
}
__device__ __forceinline__ void phase_hgrn2(const Args& A, int vb, int nvb) {
    const float* __restrict__ SLOC = (const float*)(A.ws + WS_SLOC); const float* __restrict__ DCH = (const float*)(A.ws + WS_DCH); bf16_t* __restrict__ SST = (bf16_t*)(A.ws + WS_SST);
    for (int idx = vb * NTHREADS + threadIdx.x; idx < 8 * 16384; idx += nvb * NTHREADS) { const int bh = idx >> 14, e = idx & 16383, k = e & 127, v = e >> 7; float S = 0.f;
#pragma unroll 8
        for (int c = 1; c < NCH; ++c) { const size_t cb = (size_t)(bh * NCH + c); SST[cb * 16384 + e] = (bf16_t)f2bf(S); S = DCH[cb * 128 + k] * S + SLOC[cb * 16384 + e]; }
        A.out[OFF_PST + ((size_t)bh * 128 + k) * 128 + v] = S; }
}
__device__ __forceinline__ void phase_hgrn3(const Args& A, int vb, int nvb, LAS unsigned char* lds) {
    const int tid = threadIdx.x, lane = tid & 63, wave = wave_id();
    const bf16_t* QB = (const bf16_t*)(A.ws + WS_QB); const bf16_t* KB = (const bf16_t*)(A.ws + WS_KB); const bf16_t* GB = (const bf16_t*)(A.ws + WS_GB); const bf16_t* SST = (const bf16_t*)(A.ws + WS_SST);
    bf16_t* Y = (bf16_t*)(A.ws + WS_Y);
    LAS float* bs = (LAS float*)(lds + H_BS); LAS bf16_t* VT = (LAS bf16_t*)(lds + H_VT); LAS bf16_t* QT = (LAS bf16_t*)(lds + H_QT); LAS bf16_t* KI = (LAS bf16_t*)(lds + H_KI);
    LAS bf16_t* STs = (LAS bf16_t*)(lds + H_ST); LAS bf16_t* AB = (LAS bf16_t*)(lds + H_AB);
    for (int u = vb; u < 8 * (NCH - 1); u += nvb) { const int bh = u / (NCH - 1), c = 1 + u % (NCH - 1), b = bh >> 2, h = bh & 3; const size_t r0 = (size_t)b * RB + 64 * c;
#pragma unroll
        for (int i = 0; i < 4; ++i) { const int idx = tid + NTHREADS * i, v = idx >> 4, k8 = (idx & 15) * 8; *(LAS bf16x8*)(STs + v * LDQ + k8) = *(const bf16x8*)(SST + (size_t)(bh * NCH + c) * 16384 + v * 128 + k8); }
        hgrn_load_common(A, r0, h, lds);
#pragma unroll
        for (int i = 0; i < 2; ++i) { const int idx = tid + NTHREADS * i, t = idx >> 4, k8 = (idx & 15) * 8;
            const bf16x8 qq = *(const bf16x8*)(QB + (r0 + t) * 512 + h * 128 + k8), kk = *(const bf16x8*)(KB + (r0 + t) * 512 + h * 128 + k8);
            float qo[8], ko[8];
#pragma unroll
            for (int e = 0; e < 8; ++e) { const float bb = bs[t * 128 + k8 + e]; qo[e] = bf2f((bf16_t)qq[e]) * __expf(bb); ko[e] = bf2f((bf16_t)kk[e]) * __expf(-bb); }
            u32x4 wq, wk; wq.x = pk2(qo[0], qo[1]); wq.y = pk2(qo[2], qo[3]); wq.z = pk2(qo[4], qo[5]); wq.w = pk2(qo[6], qo[7]);
            wk.x = pk2(ko[0], ko[1]); wk.y = pk2(ko[2], ko[3]); wk.z = pk2(ko[4], ko[5]); wk.w = pk2(ko[6], ko[7]);
            *(LAS u32x4*)(QT + t * LDQ + k8) = wq; *(LAS u32x4*)(KI + t * LDQ + k8) = wk; }
        __syncthreads();
        if (wave < 4) { const int mt = wave >> 1, ns = wave & 1; f32x16 acc;
#pragma unroll
            for (int r = 0; r < 16; ++r) acc[r] = 0.f;
            if (!(mt == 0 && ns == 1)) mma_tile<8>(acc, QT + mt * 32 * LDQ, LDQ, KI + ns * 32 * LDQ, LDQ, lane);
            const int s = ns * 32 + (lane & 31);
#pragma unroll
            for (int r = 0; r < 16; ++r) { const int t = mt * 32 + crow(r, lane >> 5); AB[t * LDV + s] = (bf16_t)((s <= t) ? f2bf(acc[r]) : 0u); } }
        __syncthreads();
        {   const int mt = wave >> 2, nv = wave & 3; f32x16 acc;
#pragma unroll
            for (int r = 0; r < 16; ++r) acc[r] = 0.f;
            mma_tile<8>(acc, QT + mt * 32 * LDQ, LDQ, STs + nv * 32 * LDQ, LDQ, lane);
            mma_tile<4>(acc, AB + mt * 32 * LDV, LDV, VT + nv * 32 * LDV, LDV, lane);
#pragma unroll
            for (int r = 0; r < 16; ++r) bs[(mt * 32 + crow(r, lane >> 5)) * 128 + nv * 32 + (lane & 31)] = acc[r]; }
        __syncthreads();
        {   const int t = tid >> 3, seg = (tid & 7) * 16; float o[16], ss = 0.f;
#pragma unroll
            for (int i = 0; i < 16; ++i) { o[i] = bs[t * 128 + seg + i]; ss += o[i] * o[i]; }
            ss += __shfl_xor(ss, 1); ss += __shfl_xor(ss, 2); ss += __shfl_xor(ss, 4);
            const float rstd = 1.0f / sqrtf(ss * (1.0f / 128.0f) + RMS_EPS);
            unsigned w[8];
#pragma unroll
            for (int i = 0; i < 16; i += 2) { const float g0 = bf2f(GB[(r0 + t) * 512 + h * 128 + seg + i]) * A.out_norm[seg + i], g1 = bf2f(GB[(r0 + t) * 512 + h * 128 + seg + i + 1]) * A.out_norm[seg + i + 1];
                w[i >> 1] = pk2(o[i] * rstd * g0, o[i + 1] * rstd * g1); }
            u32x4* dst = (u32x4*)(Y + (r0 + t) * 1024 + 512 + h * 128 + seg); dst[0] = (u32x4){w[0], w[1], w[2], w[3]}; dst[1] = (u32x4){w[4], w[5], w[6], w[7]}; }
        __syncthreads();
    }
}
__device__ __forceinline__ void phase_hgrn_sample(const Args& A, int vb, int nvb, LAS unsigned char* lds) {
    const int tid = threadIdx.x, v = tid & 127, kg = tid >> 7;
    const bf16_t* QB = (const bf16_t*)(A.ws + WS_QB); const bf16_t* KB = (const bf16_t*)(A.ws + WS_KB); const bf16_t* VB = (const bf16_t*)(A.ws + WS_VB); const bf16_t* GB = (const bf16_t*)(A.ws + WS_GB);
    const float* LFB = (const float*)(A.ws + WS_LFB); bf16_t* Y = (bf16_t*)(A.ws + WS_Y);
    LAS float* sm = (LAS float*)lds;
    LAS float* red = sm + 4 * 3 * 128;
    LAS float* nrm = red + 4 * 4 * 128;
    for (int u = vb; u < NS * BH; u += nvb) { const int sb = u >> 2, h = u & 3; const size_t row0 = (size_t)MP + sb * 4;
        for (int i = tid; i < 4 * 128; i += NTHREADS) { const int j = i >> 7, k = i & 127; const size_t a = (row0 + j) * 512 + h * 128 + k;
            sm[(j * 3 + 0) * 128 + k] = __expf(LFB[a]); sm[(j * 3 + 1) * 128 + k] = bf2f(KB[a]); sm[(j * 3 + 2) * 128 + k] = bf2f(QB[a]); }
        float S[32]; const float* s0 = A.state_hgrn + ((size_t)u * 128 + kg * 32) * 128 + v;
#pragma unroll
        for (int i = 0; i < 32; ++i) S[i] = s0[(size_t)i * 128];
        float vv[4];
#pragma unroll
        for (int j = 0; j < 4; ++j) vv[j] = bf2f(VB[(row0 + j) * 512 + h * 128 + v]);
        __syncthreads();
#pragma unroll
        for (int j = 0; j < 4; ++j) { float part = 0.f;
#pragma unroll
            for (int i = 0; i < 32; ++i) { const int k = kg * 32 + i; S[i] = sm[(j * 3 + 0) * 128 + k] * S[i] + sm[(j * 3 + 1) * 128 + k] * vv[j]; part += sm[(j * 3 + 2) * 128 + k] * S[i]; }
            red[(j * 4 + kg) * 128 + v] = part; }
        float* s1 = A.out + OFF_SST + ((size_t)u * 128 + kg * 32) * 128 + v;
#pragma unroll
        for (int i = 0; i < 32; ++i) s1[(size_t)i * 128] = S[i];
        __syncthreads();
        const int j = kg; const float o = (red[(j * 4 + 0) * 128 + v] + red[(j * 4 + 1) * 128 + v]) + (red[(j * 4 + 2) * 128 + v] + red[(j * 4 + 3) * 128 + v]);
        const float ssq = wave_sum(o * o); if ((tid & 63) == 0) nrm[j * 2 + ((tid >> 6) & 1)] = ssq;
        __syncthreads();
        const float rstd = 1.0f / sqrtf((nrm[j * 2] + nrm[j * 2 + 1]) * (1.0f / 128.0f) + RMS_EPS);
        Y[(row0 + j) * 1024 + 512 + h * 128 + v] = (bf16_t)f2bf(o * rstd * A.out_norm[v] * bf2f(GB[(row0 + j) * 512 + h * 128 + v]));
        __syncthreads();
    }
}
__device__ __forceinline__ void phase_final(const Args& A, int vb, int nvb) {
    const int lane = threadIdx.x & 63, gw = vb * 8 + wave_id(), NGW = nvb * 8;
    const float* TMP = (const float*)(A.ws + WS_TMP);
    f32x4 g[4];
#pragma unroll
    for (int j = 0; j < 4; ++j) g[j] = ((const f32x4*)A.post_norm)[lane + 64 * j];
    for (int r = gw; r < MT; r += NGW) { const float* xs; float* ys;
        if (r < MP) { const int b = r >= RB; const int p = r - b * RB; if (p < 128) continue; const size_t o = ((size_t)b * SEQ + (p - 128)) * 1024; xs = A.x_prompt + o; ys = A.out + OFF_YP + o; }
        else { const size_t o = (size_t)(r - MP) * 1024; xs = A.x_sample + o; ys = A.out + OFF_YS + o; }
        f32x4 t[4]; float ss = 0.f;
#pragma unroll
        for (int j = 0; j < 4; ++j) { t[j] = ((const f32x4*)(TMP + (size_t)r * 1024))[lane + 64 * j]; ss += (t[j].x * t[j].x + t[j].y * t[j].y) + (t[j].z * t[j].z + t[j].w * t[j].w); }
        ss = wave_sum(ss); const float rstd = 1.0f / sqrtf(ss * (1.0f / 1024.0f) + RMS_EPS);
#pragma unroll
        for (int j = 0; j < 4; ++j) { const f32x4 x = ((const f32x4*)xs)[lane + 64 * j]; ((f32x4*)ys)[lane + 64 * j] = x + t[j] * rstd * g[j]; }
    }
}

#define XB_TMO      128
#define XB_XCNT(j)  (256  + 64 * (j))
#define XB_XSUB(j)  (1280 + 64 * (j))
#define XB_XGEN(j)  (2304 + 64 * (j))
#define XB_TOP      3328
#define XB_TOPGEN   3392
#define XCD_BAR_WORDS 3456
#define XB_SPIN_CAP (1u << 18)

__device__ __forceinline__ unsigned xb_ld(unsigned* p)              { return __hip_atomic_load(p, __ATOMIC_RELAXED, __HIP_MEMORY_SCOPE_AGENT); }
__device__ __forceinline__ unsigned xb_add(unsigned* p, unsigned v) { return __hip_atomic_fetch_add(p, v, __ATOMIC_RELAXED, __HIP_MEMORY_SCOPE_AGENT); }
__device__ __forceinline__ unsigned xb_xcc_id() { return (unsigned)__builtin_amdgcn_s_getreg((3 << 11) | 20) & 0xFu; }
#define XB_SPIN(cond, bar) do { unsigned _sp = 0; while (cond) { __builtin_amdgcn_s_sleep(32); \
    if ((++_sp & 255u) == 0u) { if (xb_ld(&(bar)[XB_TMO])) break; if (_sp > XB_SPIN_CAP) { atomicAdd(&(bar)[XB_TMO], 1u); break; } } } } while (0)

struct XcdBarrier {
    unsigned* bar; unsigned x;
    volatile LAS unsigned* st;
};

__device__ __forceinline__ XcdBarrier xcd_barrier_post(unsigned* bar, volatile LAS unsigned* st) {
    XcdBarrier b; b.bar = bar; b.x = xb_xcc_id(); b.st = st;
    if (threadIdx.x == 0) (void)xb_add(&bar[XB_XCNT(b.x)], 1u);
    return b;
}
__device__ __forceinline__ void xcd_barrier_complete(unsigned* bar, unsigned x, unsigned& nloc, unsigned& nx) {
    const unsigned G = gridDim.x * gridDim.y * gridDim.z;
    unsigned sum, cnt, mine, sp = 0u;
    for (;;) {
        sum = 0u; cnt = 0u; mine = 0u;
#pragma unroll
        for (unsigned j = 0; j < 16; ++j) { const unsigned c = xb_ld(&bar[XB_XCNT(j)]); sum += c; cnt += (c > 0u) ? 1u : 0u; mine = (j == x) ? c : mine; }
        if (sum == G) break;
        __builtin_amdgcn_s_sleep(1);
        if ((++sp & 255u) == 0u) { if (xb_ld(&bar[XB_TMO])) break; if (sp > XB_SPIN_CAP) { atomicAdd(&bar[XB_TMO], 1u); break; } }
    }
    nloc = mine > 0u ? mine : 1u; nx = cnt > 0u ? cnt : 1u;
}

__device__ __forceinline__ void xcd_barrier(const XcdBarrier& b) {
    asm volatile("s_waitcnt vmcnt(0)" ::: "memory");
    __syncthreads();
    if (threadIdx.x == 0) {
        unsigned* bar = b.bar;
        __builtin_amdgcn_s_waitcnt(0);
        unsigned nloc = b.st[0], nx = b.st[1];
        if (nloc == 0u) { xcd_barrier_complete(bar, b.x, nloc, nx); b.st[0] = nloc; b.st[1] = nx; }
        const unsigned old = xb_add(&bar[XB_XSUB(b.x)], 1u);
        const unsigned gen = old / nloc;
        if (old + 1u == (gen + 1u) * nloc) {
            __builtin_amdgcn_fence(__ATOMIC_RELEASE, "agent");
            asm volatile("s_waitcnt vmcnt(0)" ::: "memory");
            const unsigned og = xb_add(&bar[XB_TOP], 1u);
            const unsigned tg = og / nx;
            if (og + 1u == (tg + 1u) * nx) xb_add(&bar[XB_TOPGEN], 1u);
            else XB_SPIN(xb_ld(&bar[XB_TOPGEN]) == tg, bar);
            __builtin_amdgcn_fence(__ATOMIC_ACQUIRE, "agent");
            xb_add(&bar[XB_XGEN(b.x)], 1u);
            asm volatile("s_waitcnt vmcnt(0)" ::: "memory");
        } else {
            XB_SPIN(xb_ld(&bar[XB_XGEN(b.x)]) == gen, bar);
            __builtin_amdgcn_fence(__ATOMIC_ACQUIRE, "agent");
            asm volatile("s_waitcnt vmcnt(0)" ::: "memory");
        }
    }
    __syncthreads();
}

constexpr int N_PHASES = 8;
__global__ void __launch_bounds__(NTHREADS, 2) fwd(Args A) {
    extern __shared__ __attribute__((aligned(16))) unsigned char lds_raw[];
    LAS unsigned char* lds = (LAS unsigned char*)lds_raw;
    const int G = gridDim.x, bx = blockIdx.x;
    const int vb = (G % 8 == 0) ? (bx % 8) * (G / 8) + bx / 8 : bx;
    const int lo = A.ph_lo, hi = A.ph_hi;
    LAS unsigned* xbw = (LAS unsigned*)(lds + LDS_BYTES - 64);
    if (threadIdx.x == 0) { xbw[0] = 0u; xbw[1] = 0u; }
    __syncthreads();
    XcdBarrier bar; bar.bar = (unsigned*)(A.ws + WS_CTL) + 4096 + A.li * XCD_BAR_WORDS; bar.x = 0; bar.st = nullptr;
    if (MK_FUSED) bar = xcd_barrier_post((unsigned*)(A.ws + WS_CTL) + 4096 + A.li * XCD_BAR_WORDS, (volatile LAS unsigned*)xbw);
#define SEAM(k) do { if (MK_FUSED && IN(k) && IN((k) + 1)) xcd_barrier(bar); } while (0)
#ifndef PHMASK
#define PHMASK 0xff
#endif
#define IN(k) (((PHMASK >> (k)) & 1) && lo <= (k) && (k) < hi)
    if (IN(0)) phase_prologue(A, vb, G, lds);
    SEAM(0);
    if (IN(1)) { pg8::Gemm g{(const pg8::bf16_t*)(A.ws + WS_HN), (const pg8::bf16_t*)(A.ws + WS_WIN), MT, 4096, 1024}; pg8::StaticOrder S; S.init(MT, 4096, G, bx);
        EpiIn E{A.ws, A.out, A.lb_raw}; pg8::gemm_phase<EpiIn, pg8::StaticOrder, true, true>(lds, g, S, E);
        if (bx >= 48 && bx < 64) cumsum_job(A, bx - 48, lds); }
    SEAM(1);
    if (IN(2)) phase_norms(A, vb, G);
    SEAM(2);
    if (IN(3)) { phase_attn_units(A, vb, G, lds_raw); phase_sattn_part(A, vb, G); __syncthreads(); phase_hgrn1(A, vb, G, lds); }
    SEAM(3);
    if (IN(4)) { phase_sattn_comb(A, vb, G); phase_hgrn2(A, vb, G); __syncthreads(); phase_hgrn_sample(A, vb, G, lds); }
    SEAM(4);
    if (IN(5)) phase_hgrn3(A, vb, G, lds);
    SEAM(5);
    if (IN(6)) { pg8::Gemm g{(const pg8::bf16_t*)(A.ws + WS_Y), (const pg8::bf16_t*)(A.ws + WS_WOUT), MT, 1024, 1024}; pg8::StaticOrder S; S.init(MT, 1024, G, bx);
        EpiOut E{(float*)(A.ws + WS_TMP)}; pg8::gemm_phase<EpiOut, pg8::StaticOrder, true, true>(lds, g, S, E); }
    SEAM(6);
    if (IN(7)) phase_final(A, vb, G);
#undef IN
#undef SEAM
}

extern "C" void kernel_launch(void* const* d_in, const int* in_sizes, int n_in, void* d_out, int out_size, void* d_ws, size_t ws_size, hipStream_t stream) {
    static int grid = 0;
    if (grid == 0) {
        if (n_in != 15 || out_size != (int)OUT_TOTAL || ws_size < WS_END) { fprintf(stderr, "kernel_launch: unexpected problem shape (n_in %d, out %d, ws %zu)\n", n_in, out_size, ws_size); grid = -1; return; }
        int dev = 0, cus = 0;
        if (hipGetDevice(&dev) != hipSuccess || hipDeviceGetAttribute(&cus, hipDeviceAttributeMultiprocessorCount, dev) != hipSuccess) { grid = -1; return; }
        if (hipFuncSetAttribute((const void*)fwd, hipFuncAttributeMaxDynamicSharedMemorySize, LDS_BYTES) != hipSuccess) { fprintf(stderr, "kernel_launch: hipFuncSetAttribute failed\n"); grid = -1; return; }
        int per_cu = 0;
        if (hipOccupancyMaxActiveBlocksPerMultiprocessor(&per_cu, (const void*)fwd, NTHREADS, LDS_BYTES) != hipSuccess || per_cu < 1) { fprintf(stderr, "kernel_launch: occupancy query reports %d workgroups per CU\n", per_cu); (void)hipGetLastError(); }
        grid = cus;
    }
    if (grid < 0) return;
    Args a{};
    a.x_prompt = (const float*)d_in[0]; a.x_sample = (const float*)d_in[1]; a.cache_k = (const float*)d_in[2]; a.cache_v = (const float*)d_in[3]; a.cache_logf = (const float*)d_in[4];
    a.state_hgrn = (const float*)d_in[5]; a.page_table = (const int*)d_in[6]; a.meta = (const float*)d_in[7]; a.w_in = (const float*)d_in[8]; a.b_forget = (const float*)d_in[9];
    a.lb_raw = (const float*)d_in[10]; a.out_norm = (const float*)d_in[11]; a.pre_norm = (const float*)d_in[12]; a.post_norm = (const float*)d_in[13]; a.w_out = (const float*)d_in[14];
    a.out = (float*)d_out; a.ws = (unsigned char*)d_ws;
    if (MK_FUSED) {
        if (hipMemsetAsync((char*)d_ws + WS_CTL, 0, CTL_BYTES, stream) != hipSuccess) { fprintf(stderr, "kernel_launch: memset failed\n"); return; }
#ifndef MK_CUTS
#define MK_CUTS {0, N_PHASES}
#endif
        const int cuts[] = MK_CUTS; const int nl = (int)(sizeof(cuts) / sizeof(int)) - 1;
        for (int li = 0; li < nl; ++li) { a.ph_lo = cuts[li]; a.ph_hi = cuts[li + 1]; a.li = li; hipLaunchKernelGGL(fwd, dim3(grid), dim3(NTHREADS), LDS_BYTES, stream, a); }
    } else
    for (int ph = 0; ph < N_PHASES; ++ph) { a.ph_lo = ph; a.ph_hi = ph + 1; hipLaunchKernelGGL(fwd, dim3(grid), dim3(NTHREADS), LDS_BYTES, stream, a); }
}
```
